# Optimizing an MI355X kernel written in HIP

```python
import math
import jax
import jax.numpy as jnp
from jax import lax
import numpy as np

D_MODEL = 1024
BATCH = 4
SEQ = 8192
DEPTH = 1

HEAD_DIM = 64
N_SB_HEADS = 6
DIL_GROUPS = ((128, 1), (512, 4), (2048, 16))
HG = 2
N_DIL_HEADS = HG * len(DIL_GROUPS)
N_X_HEADS = 4
N_MEM = 256
D_FF = 2816
N_BUCKETS = 32
MAX_DISTANCE = 2048
Q_BLOCK = 128
EPS = 1e-6
N_BRANCH = 3
SB_W = N_SB_HEADS * HEAD_DIM
DIL_W = N_DIL_HEADS * HEAD_DIM
DIL_OUT_W = HG * HEAD_DIM
X_W = N_X_HEADS * HEAD_DIM
IN_COLS = 3 * SB_W + 3 * DIL_W + X_W + N_BRANCH * D_MODEL

kernel_name = "hybrid_gated_stickbreak_dilated_memory_macaron"


def _rmsnorm(x, g):
    xf = x.astype(jnp.float32)
    y = xf * lax.rsqrt(jnp.mean(xf * xf, axis=-1, keepdims=True) + EPS)
    return (y * g.astype(jnp.float32)).astype(x.dtype)


def _swiglu(h, w_gu, w_down):
    a, b = jnp.split(h @ w_gu, 2, axis=-1)
    return (jax.nn.silu(a) * b) @ w_down


def _t5_bucket(dist):
    max_exact = N_BUCKETS // 2
    nf = jnp.maximum(dist, 1).astype(jnp.float32)
    large = max_exact + (jnp.log(nf / max_exact) / math.log(MAX_DISTANCE / max_exact)
                         * (N_BUCKETS - max_exact)).astype(jnp.int32)
    large = jnp.minimum(large, N_BUCKETS - 1)
    return jnp.where(dist < max_exact, dist, large)


def _stick_breaking(q, k, v):
    B, S, H, Dh = q.shape
    scale = 1.0 / math.sqrt(Dh)
    s_pos = jnp.arange(S, dtype=jnp.int32)

    def block(t0):
        qb = lax.dynamic_slice_in_dim(q, t0, Q_BLOCK, axis=1)
        z = jnp.einsum('bqhd,bkhd->bhqk', qb, k).astype(jnp.float32) * scale
        t = t0 + jnp.arange(Q_BLOCK, dtype=jnp.int32)
        causal = (s_pos[None, :] < t[:, None])[None, None]
        log_beta = jax.nn.log_sigmoid(z)
        log_keep = jnp.where(causal, jax.nn.log_sigmoid(-z), 0.0)
        after = lax.cumsum(log_keep, axis=3, reverse=True) - log_keep
        a = jnp.where(causal, jnp.exp(log_beta + after), 0.0)
        return jnp.einsum('bhqk,bkhd->bqhd', a.astype(v.dtype), v)

    starts = jnp.arange(S // Q_BLOCK, dtype=jnp.int32) * Q_BLOCK
    o = lax.map(block, starts)
    return o.transpose(1, 0, 2, 3, 4).reshape(B, S, H * Dh)


def _dilated_attention(q, k, v, rel_bias):
    B, S, _, Dh = q.shape
    qs = [q[:, :, g * HG:(g + 1) * HG] for g in range(len(DIL_GROUPS))]
    ks = [k[:, :, g * HG:(g + 1) * HG] for g in range(len(DIL_GROUPS))]
    vs = [v[:, :, g * HG:(g + 1) * HG] for g in range(len(DIL_GROUPS))]
    dists, biases = [], []
    for g, (w, d) in enumerate(DIL_GROUPS):
        dist = d * jnp.arange(w // d + 1, dtype=jnp.int32)
        dists.append(dist)
        tbl = rel_bias[:, g * HG:(g + 1) * HG].astype(jnp.float32)
        biases.append(tbl[_t5_bucket(dist)].T)

    def block(t0):
        t = t0 + jnp.arange(Q_BLOCK, dtype=jnp.int32)
        outs, lses = [], []
        for g in range(len(DIL_GROUPS)):
            qb = lax.dynamic_slice_in_dim(qs[g], t0, Q_BLOCK, axis=1)
            idx = t[:, None] - dists[g][None, :]
            valid = idx >= 0
            idx = jnp.maximum(idx, 0)
            kg = ks[g][:, idx]
            vg = vs[g][:, idx]
            logits = jnp.einsum('bqhd,bqkhd->bhqk', qb, kg).astype(jnp.float32)
            logits = logits + biases[g][None, :, None, :]
            logits = jnp.where(valid[None, None], logits, -jnp.inf)
            lse = jax.nn.logsumexp(logits, axis=-1)
            p = jnp.exp(logits - lse[..., None])
            outs.append(jnp.einsum('bhqk,bqkhd->bqhd', p.astype(vg.dtype), vg).astype(jnp.float32))
            lses.append(lse)
        wts = jax.nn.softmax(jnp.stack(lses, axis=0), axis=0)
        wts = wts.transpose(0, 1, 3, 2)[..., None]
        o = jnp.sum(wts * jnp.stack(outs, axis=0), axis=0)
        return o.astype(q.dtype).reshape(B, Q_BLOCK, HG * Dh)

    starts = jnp.arange(S // Q_BLOCK, dtype=jnp.int32) * Q_BLOCK
    o = lax.map(block, starts)
    return o.transpose(1, 0, 2, 3).reshape(B, S, HG * Dh)


def _memory_attention(q, mk, mv):
    B, S, H, Dh = q.shape
    logits = jnp.einsum('bshd,bmhd->bhsm', q, mk).astype(jnp.float32)
    p = jax.nn.softmax(logits, axis=-1)
    o = jnp.einsum('bhsm,bmhd->bshd', p.astype(mv.dtype), mv)
    return o.reshape(B, S, H * Dh)


def setup_inputs(seed: int = 0) -> dict:
    key = jax.random.key(seed)
    ks = jax.random.split(key, 24)
    f32 = jnp.float32

    def w(k, shape, fan_in, mult=1.0):
        return jax.random.normal(k, shape, f32) * (mult * fan_in ** -0.5)

    def gain(k, shape):
        return 1.0 + 0.05 * jax.random.normal(k, shape, f32)

    return {
        "x": jax.random.normal(ks[0], (BATCH, SEQ, D_MODEL), f32),
        "mem": jax.random.normal(ks[1], (BATCH, N_MEM, D_MODEL), f32),
        "rel_bias": 0.2 * jax.random.normal(ks[2], (N_BUCKETS, N_DIL_HEADS), f32),
        "ffn1_norm": gain(ks[3], (DEPTH, D_MODEL)),
        "ffn1_w_gu": w(ks[4], (DEPTH, D_MODEL, 2 * D_FF), D_MODEL),
        "ffn1_w_down": w(ks[5], (DEPTH, D_FF, D_MODEL), D_FF),
        "mix_norm": gain(ks[6], (DEPTH, D_MODEL)),
        "mem_norm": gain(ks[7], (DEPTH, D_MODEL)),
        "w_in": w(ks[8], (DEPTH, D_MODEL, IN_COLS), D_MODEL),
        "w_mem_kv": w(ks[9], (DEPTH, D_MODEL, 2 * X_W), D_MODEL),
        "dil_q_gain": gain(ks[10], (DEPTH, HEAD_DIM)),
        "dil_k_gain": gain(ks[11], (DEPTH, HEAD_DIM)),
        "x_q_gain": gain(ks[12], (DEPTH, HEAD_DIM)),
        "x_k_gain": gain(ks[13], (DEPTH, HEAD_DIM)),
        "w_br_sb": w(ks[14], (DEPTH, SB_W, D_MODEL), SB_W),
        "w_br_dil": w(ks[15], (DEPTH, DIL_OUT_W, D_MODEL), DIL_OUT_W),
        "w_br_x": w(ks[16], (DEPTH, X_W, D_MODEL), X_W),
        "w_out": w(ks[17], (DEPTH, D_MODEL, D_MODEL), D_MODEL),
        "ffn2_norm": gain(ks[18], (DEPTH, D_MODEL)),
        "ffn2_w_gu": w(ks[19], (DEPTH, D_MODEL, 2 * D_FF), D_MODEL),
        "ffn2_w_down": w(ks[20], (DEPTH, D_FF, D_MODEL), D_FF),
    }


def reference(x, mem, rel_bias, ffn1_norm, ffn1_w_gu, ffn1_w_down, mix_norm, mem_norm, w_in,
              w_mem_kv, dil_q_gain, dil_k_gain, x_q_gain, x_k_gain, w_br_sb, w_br_dil, w_br_x,
              w_out, ffn2_norm, ffn2_w_gu, ffn2_w_down):
    B, S, D = x.shape
    M = mem.shape[1]
    scale = 1.0 / math.sqrt(HEAD_DIM)
    split_at = [int(i) for i in np.cumsum([SB_W, SB_W, SB_W, DIL_W, DIL_W, DIL_W, X_W])]
    for l in range(DEPTH):
        x = x + 0.5 * _swiglu(_rmsnorm(x, ffn1_norm[l]), ffn1_w_gu[l], ffn1_w_down[l])

        h = _rmsnorm(x, mix_norm[l])
        proj = h @ w_in[l]
        q_sb, k_sb, v_sb, q_d, k_d, v_d, q_x, gates = jnp.split(proj, split_at, axis=-1)

        o_sb = _stick_breaking(q_sb.reshape(B, S, N_SB_HEADS, HEAD_DIM),
                               k_sb.reshape(B, S, N_SB_HEADS, HEAD_DIM),
                               v_sb.reshape(B, S, N_SB_HEADS, HEAD_DIM))

        qd = _rmsnorm(q_d.reshape(B, S, N_DIL_HEADS, HEAD_DIM), dil_q_gain[l]) * scale
        kd = _rmsnorm(k_d.reshape(B, S, N_DIL_HEADS, HEAD_DIM), dil_k_gain[l])
        o_dil = _dilated_attention(qd, kd, v_d.reshape(B, S, N_DIL_HEADS, HEAD_DIM), rel_bias)

        mn = _rmsnorm(mem, mem_norm[l])
        mk, mv = jnp.split(mn @ w_mem_kv[l], 2, axis=-1)
        mk = _rmsnorm(mk.reshape(B, M, N_X_HEADS, HEAD_DIM), x_k_gain[l])
        mv = mv.reshape(B, M, N_X_HEADS, HEAD_DIM)
        qx = _rmsnorm(q_x.reshape(B, S, N_X_HEADS, HEAD_DIM), x_q_gain[l]) * scale
        o_x = _memory_attention(qx, mk, mv)

        g = jax.nn.sigmoid(gates.astype(jnp.float32)).reshape(B, S, N_BRANCH, D).astype(x.dtype)
        merged = (g[:, :, 0] * (o_sb @ w_br_sb[l])
                  + g[:, :, 1] * (o_dil @ w_br_dil[l])
                  + g[:, :, 2] * (o_x @ w_br_x[l]))
        x = x + merged @ w_out[l]

        x = x + 0.5 * _swiglu(_rmsnorm(x, ffn2_norm[l]), ffn2_w_gu[l], ffn2_w_down[l])
    return x
```

```cpp
#include <hip/hip_runtime.h>
#include <cstdint>
#include <cstdio>

constexpr int NB = 4, S = 8192, D = 1024, M = NB * S;
constexpr int FF = 2816, NGU = 2 * FF;
constexpr int HD = 64;
constexpr int NQKV = 2560, NGATE = 3072, INCOLS = NQKV + NGATE;
constexpr int QKVP = 2624;
constexpr int NMEM = 256, MROWS = NB * NMEM;
constexpr int NOC = 768;
constexpr float EPS = 1e-6f;
constexpr float LOG2E = 1.4426950408889634f;
constexpr float QSCALE = 0.125f * LOG2E;

typedef unsigned short bf16_t;
__device__ __forceinline__ float bf2f(bf16_t v) { return __uint_as_float(((unsigned)v) << 16); }
__device__ __forceinline__ bf16_t f2bf(float f) { unsigned u = __float_as_uint(f); return (bf16_t)((u + 0x7fffu + ((u >> 16) & 1u)) >> 16); }

constexpr size_t MiB = 1u << 20;
constexpr size_t WS_CTL = 0, CTL_ZERO_BYTES = 1 * MiB;
constexpr size_t WS_SS1 = 256 * 1024, WS_SS2 = 384 * 1024, WS_RSTD0 = 512 * 1024, WS_BIAS = 768 * 1024;
constexpr size_t WS_WGU1 = 2 * MiB, WS_WD1 = 13 * MiB, WS_WIN = 19 * MiB, WS_WGU2 = 30 * MiB, WS_WD2 = 41 * MiB, WS_WOUT = 47 * MiB, WS_WSB = 49 * MiB  , WS_WDIL = 51 * MiB, WS_WX = 52 * MiB, WS_WSB2 = 53 * MiB;
constexpr size_t WS_MK = 54 * MiB, WS_MVT = 55 * MiB;
constexpr size_t WS_XB = 64 * MiB;
constexpr size_t WS_BIG = 128 * MiB;
constexpr size_t WS_G = 296 * MiB;
constexpr size_t WS_END = 488 * MiB;
static_assert(WS_WGU1 + (size_t)NGU * D * 2 <= WS_WD1 && WS_WD1 + (size_t)D * FF * 2 <= WS_WIN && WS_WIN + (size_t)INCOLS * D * 2 <= WS_WGU2 && WS_WGU2 + (size_t)NGU * D * 2 <= WS_WD2 &&
              WS_WD2 + (size_t)D * FF * 2 <= WS_WOUT && WS_WOUT + (size_t)D * D * 2 <= WS_WSB && WS_XB + (size_t)M * D * 2 <= WS_BIG && WS_BIG + (size_t)M * QKVP * 2 <= WS_G && WS_G + (size_t)M * NGATE * 2 <= WS_END, "d_ws map");

__device__ const unsigned char T5B[3][129] = {
 {0,1,2,3,4,5,6,7,8,9,10,11,12,13,14,15,16,16,16,16,16,16,17,17,17,17,17,17,17,17,18,18,18,18,18,18,18,18,18,18,19,19,19,19,19,19,19,19,19,19,19,19,19,19,20,20,20,20,20,20,20,20,20,20,20,20,20,20,20,20,20,20,20,21,21,21,21,21,21,21,21,21,21,21,21,21,21,21,21,21,21,21,21,21,21,21,21,21,21,22,22,22,22,22,22,22,22,22,22,22,22,22,22,22,22,22,22,22,22,22,22,22,22,22,22,22,22,22,22},
 {0,4,8,12,16,16,17,17,18,18,19,19,19,19,20,20,20,20,20,21,21,21,21,21,21,22,22,22,22,22,22,22,22,22,23,23,23,23,23,23,23,23,23,23,23,23,24,24,24,24,24,24,24,24,24,24,24,24,24,24,24,24,25,25,25,25,25,25,25,25,25,25,25,25,25,25,25,25,25,25,25,25,25,26,26,26,26,26,26,26,26,26,26,26,26,26,26,26,26,26,26,26,26,26,26,26,26,26,26,26,26,26,26,27,27,27,27,27,27,27,27,27,27,27,27,27,27,27,27},
 {0,16,18,19,20,21,21,22,22,23,23,23,24,24,24,24,25,25,25,25,25,26,26,26,26,26,26,26,26,27,27,27,27,27,27,27,27,27,27,28,28,28,28,28,28,28,28,28,28,28,28,28,29,29,29,29,29,29,29,29,29,29,29,29,29,29,29,29,29,29,30,30,30,30,30,30,30,30,30,30,30,30,30,30,30,30,30,30,30,30,30,30,30,30,30,31,31,31,31,31,31,31,31,31,31,31,31,31,31,31,31,31,31,31,31,31,31,31,31,31,31,31,31,31,31,31,31,31,31}};

struct Ptrs {
    const float *x, *mem, *rel_bias, *ffn1_norm, *ffn1_w_gu, *ffn1_w_down, *mix_norm, *mem_norm, *w_in, *w_mem_kv,
                *dil_q_gain, *dil_k_gain, *x_q_gain, *x_k_gain, *w_br_sb, *w_br_dil, *w_br_x, *w_out, *ffn2_norm, *ffn2_w_gu, *ffn2_w_down;
    float* out; unsigned char* ws;
};

#ifndef PG8_USE_SP2
#define PG8_USE_SP2 1
#endif
namespace pg8 {
#define PG8_LAS __attribute__((address_space(3)))
typedef short bf16x8 __attribute__((ext_vector_type(8)));
typedef float f32x4 __attribute__((ext_vector_type(4)));
typedef float f32x2 __attribute__((ext_vector_type(2)));
typedef unsigned u32x4 __attribute__((ext_vector_type(4)));
typedef unsigned u32x2 __attribute__((ext_vector_type(2)));
constexpr int BM = 256, BK = 64, HALF = 128, HTB = HALF * BK * 2  , STAGE_BYTES = 8 * HTB, NXCD = 8, WGM = 8;

__host__ __device__ __forceinline__ int lds_byte(int r, int c) { const int st = (r >> 4) * 2 + (c >> 5), rr = r & 15, cc = c & 31, ob = rr * 64 + cc * 2; return st * 1024 + (ob ^ (((ob >> 9) & 1) << 5)); }
__host__ __device__ __forceinline__ void stage_rc(int b, int& R, int& C) { const int st = b / 1024, sb = b % 1024, swz = sb ^ (((sb >> 9) & 1) << 5); R = (st >> 1) * 16 + swz / 64; C = (st & 1) * 32 + (swz % 64) / 2; }
__host__ __device__ __forceinline__ int perm32(int rho) { const int n = rho >> 4, i = rho & 15; return 8 * (i >> 2) + 4 * n + (i & 3); }

struct Unit { int pm, pn; };
struct Gemm { const bf16_t* A; const bf16_t* Bt; int M, N, K, lda; };

struct StaticOrder {
    int nM, nN, nwg, G, c;
    __host__ __device__ void init(int M_, int N_, int G_, int c_) { nM = M_ / BM; nN = N_ / BM; nwg = nM * nN; G = G_; c = c_; }
    __host__ __device__ bool next(int i, Unit& u) const {
        const long L = (long)i * G + c; if (L >= nwg) return false;
        int wgid = (int)L; { const int q = nwg / NXCD, r = nwg % NXCD, xcd = wgid % NXCD, off = wgid / NXCD; wgid = (xcd < r ? xcd * (q + 1) : r * (q + 1) + (xcd - r) * q) + off; }
        const int nig = WGM * nN, gid = wgid / nig, fm = gid * WGM, gsz = (nM - fm) < WGM ? (nM - fm) : WGM;
        u.pm = fm + ((wgid % nig) % gsz); u.pn = (wgid % nig) / gsz; return true;
    }
};

typedef float f32x2_t __attribute__((ext_vector_type(2))); typedef __bf16 bf16x2_t __attribute__((ext_vector_type(2)));
__device__ __forceinline__ unsigned cvt_pk_bf16(float lo, float hi) { const f32x2_t v = {lo, hi}; return __builtin_bit_cast(unsigned, __builtin_convertvector(v, bf16x2_t)); }
__device__ __forceinline__ float fast_sigmoid(float v) { return __builtin_amdgcn_rcpf(1.0f + __builtin_amdgcn_exp2f(-LOG2E * v)); }
__device__ __forceinline__ unsigned gate_q4(f32x4 v) { unsigned w = 0;
#pragma unroll
    for (int i = 0; i < 4; ++i) w = __builtin_amdgcn_cvt_pk_u8_f32(v[i] * 16.0f + 128.0f, i, w);
    return w; }
__device__ __forceinline__ f32x4 gate_dq4(unsigned w) { f32x4 g;
#pragma unroll
    for (int i = 0; i < 4; ++i) g[i] = ((float)((w >> (8 * i)) & 255u) - 128.0f) * 0.0625f;
    return g; }
__device__ __forceinline__ float row_rstd(const float* rstd, const float* ss, int row) { return rstd ? rstd[row] : __builtin_amdgcn_rsqf(ss[row] * (1.0f / D) + EPS); }

struct EpiFfnUp {
    static constexpr bool PERM = true, FOLD = false, EPI_TWICE = false, EPI_DRY = false; static constexpr int TOUCH = 0;
    bf16_t* H; const float* rstd; const float* ss;
    __device__ __forceinline__ void operator()(const f32x4 (&acc)[2][2][4][2], const Unit& u, int wr, int wc, int fr, int fq) const {
        const int row0 = u.pm * BM + wr * 64 + fr, col0 = u.pn * 128 + wc * 32 + 8 * fq;
#pragma unroll
        for (int ai = 0; ai < 2; ++ai)
#pragma unroll
            for (int m = 0; m < 4; ++m) { const int row = row0 + ai * HALF + m * 16; const float r = row_rstd(rstd, ss, row); float h[8];
#pragma unroll
                for (int n = 0; n < 2; ++n)
#pragma unroll
                    for (int i = 0; i < 4; ++i) { const float a = acc[ai][0][m][n][i] * r, b = acc[ai][1][m][n][i] * r; h[n * 4 + i] = a * fast_sigmoid(a) * b; }
                u32x4 w; w.x = cvt_pk_bf16(h[0], h[1]); w.y = cvt_pk_bf16(h[2], h[3]); w.z = cvt_pk_bf16(h[4], h[5]); w.w = cvt_pk_bf16(h[6], h[7]);
                __builtin_nontemporal_store(w, (u32x4*)(H + (size_t)row * FF + col0)); }
    }
};
template <bool RES_BF16, bool OUT_F32, bool OUT_BF16> struct EpiRes {
    static constexpr bool PERM = false, FOLD = false, EPI_TWICE = false, EPI_DRY = false;
    static constexpr int TOUCH = 0;
    static constexpr int NB = RES_BF16 ? 1 : 2;
    const float* resf; const bf16_t* resb; float* out; bf16_t* xb; float* ss; float alpha;
    __device__ __forceinline__ void operator()(const f32x4 (&acc)[2][2][4][2], const Unit& u, int wr, int wc, int fr, int fq) const {
        const int row0 = u.pm * BM + wr * 64 + fr, col0 = u.pn * BM + wc * 32 + 4 * fq;
#pragma unroll
        for (int bt = 0; bt < NB; ++bt) {
            f32x4 rvf[RES_BF16 ? 1 : 1][RES_BF16 ? 1 : 4][2][2]; u32x2 rvb[RES_BF16 ? 2 : 1][RES_BF16 ? 4 : 1][2][2];
#pragma unroll
            for (int a2 = 0; a2 < 2 / NB; ++a2)
#pragma unroll
                for (int m = 0; m < 4; ++m) { const int ai = bt * (2 / NB) + a2; const size_t off = (size_t)(row0 + ai * HALF + m * 16) * D + col0;
#pragma unroll
                    for (int bj = 0; bj < 2; ++bj)
#pragma unroll
                        for (int n = 0; n < 2; ++n) { if (RES_BF16) rvb[a2][m][bj][n] = *(const u32x2*)(resb + off + bj * HALF + n * 16); else rvf[0][m][bj][n] = *(const f32x4*)(resf + off + bj * HALF + n * 16); } }
            asm volatile("" ::: "memory");
#pragma unroll
            for (int a2 = 0; a2 < 2 / NB; ++a2)
#pragma unroll
                for (int m = 0; m < 4; ++m) { const int ai = bt * (2 / NB) + a2, row = row0 + ai * HALF + m * 16; const size_t off = (size_t)row * D + col0; float s = 0.f;
#pragma unroll
                    for (int bj = 0; bj < 2; ++bj)
#pragma unroll
                        for (int n = 0; n < 2; ++n) {
                            f32x4 rv;
                            if (RES_BF16) { const u32x2 w = rvb[a2][m][bj][n]; rv = (f32x4){__uint_as_float(w.x << 16), __uint_as_float(w.x & 0xffff0000u), __uint_as_float(w.y << 16), __uint_as_float(w.y & 0xffff0000u)}; }
                            else rv = rvf[0][m][bj][n];
                            const f32x4 o = rv + acc[ai][bj][m][n] * alpha;
                            if (OUT_F32) *(f32x4*)(out + off + bj * HALF + n * 16) = o;
                            s += (o[0] * o[0] + o[1] * o[1]) + (o[2] * o[2] + o[3] * o[3]);
                            if (OUT_BF16) { u32x2 w; w.x = cvt_pk_bf16(o[0], o[1]); w.y = cvt_pk_bf16(o[2], o[3]); *(u32x2*)(xb + off + bj * HALF + n * 16) = w; } }
                    if (ss) { s += __shfl_xor(s, 16); s += __shfl_xor(s, 32); if (fq == 0) atomicAdd(ss + row, s); } }
            asm volatile("" ::: "memory"); }
    }
};
struct EpiWin {
    static constexpr bool PERM = true, FOLD = false, EPI_TWICE = false, EPI_DRY = false; static constexpr int TOUCH = 0;
    bf16_t* QKV; unsigned char* G; const float* ss1; const float *gq, *gk, *gxq; bf16_t* dry; bf16_t* drybase;
    __device__ __forceinline__ void operator()(const f32x4 (&acc)[2][2][4][2], const Unit& u, int wr, int wc, int fr, int fq) const {
        const int row0 = u.pm * BM + wr * 64 + fr;
        if (u.pn >= 10) {
            const int col0 = (u.pn - 10) * BM + wc * 64 + 8 * fq;
#pragma unroll
            for (int ai = 0; ai < 2; ++ai)
#pragma unroll
                for (int m = 0; m < 4; ++m) { const int row = row0 + ai * HALF + m * 16; const float r = row_rstd(nullptr, ss1, row);
#pragma unroll
                    for (int bj = 0; bj < 2; ++bj) { const f32x4 v0 = acc[ai][bj][m][0] * r, v1 = acc[ai][bj][m][1] * r; u32x2 w;
                        w.x = gate_q4(v0); w.y = gate_q4(v1);
                        __builtin_nontemporal_store(w, (u32x2*)(G + (size_t)row * NGATE + col0 + bj * 32)); } }
            return;
        }
        const int head = 4 * u.pn + wc;
        const bool norm = (head >= 18 && head < 30) || head >= 36;
        const float* gain = (head >= 18 && head < 24) ? gq : (head >= 24 && head < 30) ? gk : (head >= 36) ? gxq : nullptr;
        const float cs = (head < 6 || (head >= 18 && head < 24) || head >= 36) ? QSCALE : 1.0f;
        f32x4 mul[2][2];
#pragma unroll
        for (int bj = 0; bj < 2; ++bj)
#pragma unroll
            for (int n = 0; n < 2; ++n) { f32x4 g = {1.f, 1.f, 1.f, 1.f}; if (gain) g = *(const f32x4*)(gain + 32 * bj + 8 * fq + 4 * n); mul[bj][n] = g * cs; }
#pragma unroll
        for (int ai = 0; ai < 2; ++ai)
#pragma unroll
            for (int m = 0; m < 4; ++m) { const int row = row0 + ai * HALF + m * 16; const float r = row_rstd(nullptr, ss1, row); f32x4 v[2][2]; float s = 0.f;
#pragma unroll
                for (int bj = 0; bj < 2; ++bj)
#pragma unroll
                    for (int n = 0; n < 2; ++n) { v[bj][n] = acc[ai][bj][m][n] * r; const f32x4 t = v[bj][n]; s += (t[0] * t[0] + t[1] * t[1]) + (t[2] * t[2] + t[3] * t[3]); }
                float hr = 1.0f;
                if (norm) { s += __shfl_xor(s, 16); s += __shfl_xor(s, 32); hr = __builtin_amdgcn_rsqf(s * (1.0f / HD) + EPS); }
#pragma unroll
                for (int bj = 0; bj < 2; ++bj) { const f32x4 v0 = v[bj][0] * mul[bj][0] * hr, v1 = v[bj][1] * mul[bj][1] * hr; u32x4 w;
                    w.x = cvt_pk_bf16(v0[0], v0[1]); w.y = cvt_pk_bf16(v0[2], v0[3]); w.z = cvt_pk_bf16(v1[0], v1[1]); w.w = cvt_pk_bf16(v1[2], v1[3]);
                    __builtin_nontemporal_store(w, (u32x4*)(QKV + ((size_t)head * M + row) * 64 + bj * 32 + 8 * fq)); } }
    }
};
template <int STEP> struct EpiBranch {
    static constexpr bool PERM = false, FOLD = false, EPI_TWICE = false, EPI_DRY = false; static constexpr int TOUCH = 0;
    static constexpr int NB = STEP > 0 ? 2 : 1;
    const unsigned char* G; bf16_t* macc; bf16_t* merged;
    static __device__ __forceinline__ f32x4 up4(u32x2 w) { return (f32x4){__uint_as_float(w.x << 16), __uint_as_float(w.x & 0xffff0000u), __uint_as_float(w.y << 16), __uint_as_float(w.y & 0xffff0000u)}; }
    __device__ __forceinline__ void operator()(const f32x4 (&acc)[2][2][4][2], const Unit& u, int wr, int wc, int fr, int fq) const {
        const int row0 = u.pm * BM + wr * 64 + fr, col0 = u.pn * BM + wc * 32 + 4 * fq;
#pragma unroll
        for (int bt = 0; bt < NB; ++bt) {
            unsigned gw[2 / NB][4][2][2]; u32x2 mw[STEP > 0 ? 1 : 1][STEP > 0 ? 4 : 1][2][2];
#pragma unroll
            for (int a2 = 0; a2 < 2 / NB; ++a2)
#pragma unroll
                for (int m = 0; m < 4; ++m) { const int ai = bt * (2 / NB) + a2, row = row0 + ai * HALF + m * 16;
#pragma unroll
                    for (int bj = 0; bj < 2; ++bj)
#pragma unroll
                        for (int n = 0; n < 2; ++n) { const int col = col0 + bj * HALF + n * 16; gw[a2][m][bj][n] = *(const unsigned*)(G + (size_t)row * NGATE + col + STEP * D);
                            if (STEP > 0) mw[0][m][bj][n] = *(const u32x2*)(macc + (size_t)row * D + col); } }
            asm volatile("" ::: "memory");
#pragma unroll
            for (int a2 = 0; a2 < 2 / NB; ++a2)
#pragma unroll
                for (int m = 0; m < 4; ++m) { const int ai = bt * (2 / NB) + a2, row = row0 + ai * HALF + m * 16;
#pragma unroll
                    for (int bj = 0; bj < 2; ++bj)
#pragma unroll
                        for (int n = 0; n < 2; ++n) { const int col = col0 + bj * HALF + n * 16;
                            f32x4 g = gate_dq4(gw[a2][m][bj][n]);
#pragma unroll
                            for (int i = 0; i < 4; ++i) g[i] = fast_sigmoid(g[i]);
                            f32x4 v = g * acc[ai][bj][m][n];
                            if (STEP > 0) v += up4(mw[0][m][bj][n]);
                            u32x2 w; w.x = cvt_pk_bf16(v[0], v[1]); w.y = cvt_pk_bf16(v[2], v[3]);
                            *(u32x2*)((STEP < 2 ? macc : merged) + (size_t)row * D + col) = w; } }
            asm volatile("" ::: "memory"); }
    }
};

template <class Epi, class Sched>
__device__ __forceinline__ void gemm_phase(PG8_LAS unsigned char* lds, const Gemm g, const Sched& S, const Epi& E, const int wid  ) {
    int lane; asm volatile("v_mbcnt_lo_u32_b32 %0, -1, 0\n\tv_mbcnt_hi_u32_b32 %0, -1, %0" : "=v"(lane));
    const int tid = wid * 64 + lane, wr = wid >> 2, wc = wid & 3, fr = lane & 15, fq = lane >> 4;
    const int K = g.K, nt = K / BK, lda = g.lda;
    unsigned voffA[2], voffB[2];
#pragma unroll
    for (int i = 0; i < 2; ++i) { int R, C; stage_rc(tid * 16 + i * 8192, R, C); const int Rb = Epi::PERM ? ((R & ~31) + perm32(R & 31)) : R;
        voffA[i] = (unsigned)(R * lda + C) * 2u; voffB[i] = (unsigned)(Rb * K + C) * 2u; }
    const size_t kstep = (size_t)(BK * 2);
    const size_t hsA = (size_t)HALF * lda * 2, hsB = (size_t)HALF * K * 2;
    const size_t tsA = 2 * hsA, tsB = 2 * hsB;
    const unsigned ldsw = (unsigned)wid * 1024u;
    const int aoff = lds_byte(wr * 64 + fr, fq * 8), boff = lds_byte(wc * 32 + fr, fq * 8);
#define PG8_SA(b, h) (((b) * 2 + (h)) * HTB)
#define PG8_SB(b, h) ((4 + (b) * 2 + (h)) * HTB)
#define PG8_STAGE(bufoff, gbase, voff) do { _Pragma("unroll") for (int _i = 0; _i < 2; ++_i) \
        __builtin_amdgcn_global_load_lds((const unsigned*)((const char*)(gbase) + (voff)[_i]), (PG8_LAS unsigned*)(lds + (bufoff) + ldsw + _i * 8192), 16, 0, 0); } while (0)
    PG8_LAS const unsigned char* ldsA = lds + aoff; PG8_LAS const unsigned char* ldsB = lds + 4 * HTB + boff;
    asm volatile("" : "+v"(ldsA), "+v"(ldsB));
#define PG8_LDA(dst, b, h) do { _Pragma("unroll") for (int m = 0; m < 4; ++m) _Pragma("unroll") for (int k = 0; k < 2; ++k) dst[m][k] = *(const PG8_LAS bf16x8*)(ldsA + ((b) * 2 + (h)) * HTB + m * 2048 + k * 1024); } while (0)
#define PG8_LDB(dst, b, h) do { _Pragma("unroll") for (int n = 0; n < 2; ++n) _Pragma("unroll") for (int k = 0; k < 2; ++k) dst[n][k] = *(const PG8_LAS bf16x8*)(ldsB + ((b) * 2 + (h)) * HTB + n * 2048 + k * 1024); } while (0)
#define PG8_MMA(ai, bj, At, Bt) do { __builtin_amdgcn_s_setprio(1); _Pragma("unroll") for (int m = 0; m < 4; ++m) _Pragma("unroll") for (int n = 0; n < 2; ++n) _Pragma("unroll") for (int k = 0; k < 2; ++k) \
        acc[ai][bj][m][n] = __builtin_amdgcn_mfma_f32_16x16x32_bf16(Bt[n][k], At[m][k], acc[ai][bj][m][n], 0, 0, 0); __builtin_amdgcn_s_setprio(0); } while (0)
#define PG8_WAIT_V(n) asm volatile("s_waitcnt vmcnt(" #n ")" ::: "memory")
#define PG8_WAIT_L(n) asm volatile("s_waitcnt lgkmcnt(" #n ")" ::: "memory")
#define PG8_BAR __builtin_amdgcn_s_barrier()
#define PG8_SCHED __builtin_amdgcn_sched_barrier(0)
#if !PG8_USE_SP2
#define PG8_KTILE2(t) do { \
            const bool last = (t == nt - 2); \
            const char* a1 = cA + (size_t)(t + 1) * kstep; \
            const char* a2 = last ? nA : cA + (size_t)(t + 2) * kstep; const char* b2 = last ? nB : cB + (size_t)(t + 2) * kstep; \
            const char* a3 = a2 + kstep; const char* b3 = b2 + kstep; \
            PG8_LDB(B0, 0, 0); PG8_SCHED; PG8_LDA(At, 0, 0); PG8_STAGE(PG8_SA(1, 1), a1 + hsA, voffA); \
            PG8_WAIT_L(8); PG8_BAR; PG8_WAIT_L(0); PG8_MMA(0, 0, At, B0); PG8_BAR; PG8_SCHED; \
            PG8_LDB(B1, 0, 1); PG8_STAGE(PG8_SB(0, 0), b2, voffB); \
            PG8_BAR; PG8_WAIT_L(0); PG8_MMA(0, 1, At, B1); PG8_BAR; \
            PG8_LDA(At, 0, 1); PG8_STAGE(PG8_SA(0, 0), a2, voffA); \
            PG8_BAR; PG8_WAIT_L(0); PG8_MMA(1, 0, At, B0); PG8_BAR; PG8_SCHED; \
            PG8_STAGE(PG8_SB(0, 1), b2 + hsB, voffB); \
            PG8_WAIT_V(6); PG8_BAR; PG8_MMA(1, 1, At, B1); PG8_BAR; \
            PG8_LDB(B0, 1, 0); PG8_SCHED; PG8_LDA(At, 1, 0); PG8_STAGE(PG8_SA(0, 1), a2 + hsA, voffA); \
            PG8_WAIT_L(8); PG8_BAR; PG8_WAIT_L(0); PG8_MMA(0, 0, At, B0); PG8_BAR; PG8_SCHED; \
            PG8_LDB(B1, 1, 1); PG8_STAGE(PG8_SB(1, 0), b3, voffB); \
            PG8_BAR; PG8_WAIT_L(0); PG8_MMA(0, 1, At, B1); PG8_BAR; \
            PG8_LDA(At, 1, 1); PG8_STAGE(PG8_SA(1, 0), a3, voffA); \
            PG8_BAR; PG8_WAIT_L(0); PG8_MMA(1, 0, At, B0); PG8_BAR; PG8_SCHED; \
            PG8_STAGE(PG8_SB(1, 1), b3 + hsB, voffB); \
            PG8_WAIT_V(6); PG8_BAR; PG8_MMA(1, 1, At, B1); PG8_BAR; \
        } while (0)
#else
#define PG8_KTILE2(t) do { \
            const bool last = (t == nt - 2); \
            const char* a1 = cA + (size_t)(t + 1) * kstep; \
            const char* a2 = last ? nA : cA + (size_t)(t + 2) * kstep; const char* b2 = last ? nB : cB + (size_t)(t + 2) * kstep; \
            const char* a3 = a2 + kstep; const char* b3 = b2 + kstep; \
            PG8_LDB(B0, 0, 0); PG8_LDB(B1, 0, 1); PG8_SCHED; PG8_LDA(At, 0, 0); PG8_STAGE(PG8_SA(1, 1), a1 + hsA, voffA); \
            PG8_WAIT_V(8); PG8_WAIT_L(0); PG8_BAR; PG8_MMA(0, 0, At, B0); PG8_MMA(0, 1, At, B1); PG8_BAR; PG8_SCHED; \
            PG8_LDA(At, 0, 1); PG8_STAGE(PG8_SB(0, 0), b2, voffB); PG8_STAGE(PG8_SB(0, 1), b2 + hsB, voffB); PG8_STAGE(PG8_SA(0, 0), a2, voffA); \
            PG8_WAIT_V(8); PG8_WAIT_L(0); PG8_BAR; PG8_MMA(1, 0, At, B0); PG8_MMA(1, 1, At, B1); PG8_BAR; PG8_SCHED; \
            PG8_LDB(B0, 1, 0); PG8_LDB(B1, 1, 1); PG8_SCHED; PG8_LDA(At, 1, 0); PG8_STAGE(PG8_SA(0, 1), a2 + hsA, voffA); \
            PG8_WAIT_V(8); PG8_WAIT_L(0); PG8_BAR; PG8_MMA(0, 0, At, B0); PG8_MMA(0, 1, At, B1); PG8_BAR; PG8_SCHED; \
            PG8_LDA(At, 1, 1); PG8_STAGE(PG8_SB(1, 0), b3, voffB); PG8_STAGE(PG8_SB(1, 1), b3 + hsB, voffB); PG8_STAGE(PG8_SA(1, 0), a3, voffA); \
            PG8_WAIT_V(8); PG8_WAIT_L(0); PG8_BAR; PG8_MMA(1, 0, At, B0); PG8_MMA(1, 1, At, B1); PG8_BAR; PG8_SCHED; \
        } while (0)
#endif
    Unit cur, nxt; int ui = 0;
    if (!S.next(0, cur)) return;
    f32x4 acc[2][2][4][2];
#pragma unroll
    for (int a = 0; a < 2; ++a)
#pragma unroll
        for (int b = 0; b < 2; ++b)
#pragma unroll
            for (int m = 0; m < 4; ++m)
#pragma unroll
                for (int n = 0; n < 2; ++n) acc[a][b][m][n] = (f32x4){0.f, 0.f, 0.f, 0.f};
    bf16x8 At[4][2], B0[2][2], B1[2][2];
    const char* cA = (const char*)g.A + (size_t)cur.pm * tsA; const char* cB = (const char*)g.Bt + (size_t)cur.pn * tsB;
#if PG8_USE_SP2
    PG8_STAGE(PG8_SB(0, 0), cB, voffB); PG8_STAGE(PG8_SB(0, 1), cB + hsB, voffB); PG8_STAGE(PG8_SA(0, 0), cA, voffA); PG8_STAGE(PG8_SA(0, 1), cA + hsA, voffA);
    if (wr == 1) PG8_BAR;
    PG8_WAIT_V(2); PG8_BAR;
#else
    PG8_STAGE(PG8_SB(0, 0), cB, voffB); PG8_STAGE(PG8_SA(0, 0), cA, voffA); PG8_STAGE(PG8_SB(0, 1), cB + hsB, voffB); PG8_STAGE(PG8_SA(0, 1), cA + hsA, voffA);
    if (wr == 1) PG8_BAR;
    PG8_WAIT_V(4); PG8_BAR;
#endif
    PG8_STAGE(PG8_SB(1, 0), cB + kstep, voffB); PG8_STAGE(PG8_SA(1, 0), cA + kstep, voffA); PG8_STAGE(PG8_SB(1, 1), cB + hsB + kstep, voffB);
    PG8_WAIT_V(6); PG8_BAR;
    for (;;) {
        const bool has_next = S.next(ui + 1, nxt);
        const char* nA = has_next ? (const char*)g.A + (size_t)nxt.pm * tsA : cA; const char* nB = has_next ? (const char*)g.Bt + (size_t)nxt.pn * tsB : cB;
        if constexpr (Epi::FOLD) {
            static_assert(Epi::NT == 12 && Epi::F1 == 6 && Epi::F2 == 8, "the fold walk below is written out for K = 384 | 128 | 256");
            PG8_KTILE2(0); PG8_KTILE2(2); PG8_KTILE2(4);
            PG8_SCHED; E.fold(acc, cur, 0, wr, wc, fr, fq); PG8_SCHED;
            PG8_KTILE2(6);
            PG8_SCHED; E.fold(acc, cur, 1, wr, wc, fr, fq); PG8_SCHED;
            PG8_KTILE2(8); PG8_KTILE2(10);
        } else {
            for (int t = 0; t < nt; t += 2) { if constexpr (Epi::TOUCH > 0) { if (t < 2 * Epi::TOUCH) E.touch(cur, t >> 1, wid, lane, lds); } PG8_KTILE2(t); }
        }
        if (wr == 0) PG8_BAR;
        E(acc, cur, wr, wc, fr, fq);
        if constexpr (Epi::EPI_TWICE) { asm volatile("" ::: "memory"); E(acc, cur, wr, wc, fr, fq); }
        if constexpr (Epi::EPI_DRY) { asm volatile("" ::: "memory"); Epi E2 = E; E2.dry = E.drybase + (size_t)(blockIdx.x * 8 + wid) * 512; E2(acc, cur, wr, wc, fr, fq); }
        if (!has_next) break;
#pragma unroll
        for (int a = 0; a < 2; ++a)
#pragma unroll
            for (int b = 0; b < 2; ++b)
#pragma unroll
                for (int m = 0; m < 4; ++m)
#pragma unroll
                    for (int n = 0; n < 2; ++n) acc[a][b][m][n] = (f32x4){0.f, 0.f, 0.f, 0.f};
        cur = nxt; cA = nA; cB = nB; ++ui;
        if (wr == 1) PG8_BAR;
    }
    PG8_WAIT_V(0);
    PG8_BAR;
#undef PG8_SA
#undef PG8_SB
#undef PG8_STAGE
#undef PG8_LDA
#undef PG8_LDB
#undef PG8_MMA
#undef PG8_WAIT_V
#undef PG8_WAIT_L
#undef PG8_BAR
#undef PG8_SCHED
#undef PG8_KTILE2
}
}

namespace att {
#define ATT_LAS __attribute__((address_space(3)))
typedef short bf16x8 __attribute__((ext_vector_type(8)));
typedef short s16x4 __attribute__((ext_vector_type(4)));
typedef float f32x16 __attribute__((ext_vector_type(16)));
typedef unsigned u32x2 __attribute__((ext_vector_type(2)));
typedef unsigned u32x4 __attribute__((ext_vector_type(4)));
constexpr int KSTRIDE = 144, KSTAGE = 32 * KSTRIDE;
constexpr int VSTRIDE = 192, VSTAGE = 32 * VSTRIDE;
constexpr int WSTAGE = KSTAGE + VSTAGE;
constexpr int TBLN = 132;
constexpr int LDS_TBL = 0, LDS_VST = 4096, LDS_BYTES = LDS_VST + 8 * WSTAGE;
constexpr float NEG = -1e30f;
__device__ __forceinline__ int crow(int r, int hi) { return (r & 3) + 8 * (r >> 2) + 4 * hi; }
typedef float f32x2_t __attribute__((ext_vector_type(2))); typedef __bf16 bf16x2_t __attribute__((ext_vector_type(2)));
__device__ __forceinline__ unsigned cvtpk(float lo, float hi) { const f32x2_t v = {lo, hi}; return __builtin_bit_cast(unsigned, __builtin_convertvector(v, bf16x2_t)); }

__device__ __forceinline__ void load_frag4(bf16x8 (&f)[4], const bf16_t* rowp, int hi) {
#pragma unroll
    for (int d0 = 0; d0 < 4; ++d0) f[d0] = *(const bf16x8*)(rowp + d0 * 16 + hi * 8);
}
__device__ __forceinline__ f32x16 qk_tile(const bf16x8 (&kf)[4], const bf16x8 (&qf)[4]) {
    f32x16 s = {0.f, 0.f, 0.f, 0.f, 0.f, 0.f, 0.f, 0.f, 0.f, 0.f, 0.f, 0.f, 0.f, 0.f, 0.f, 0.f};
#pragma unroll
    for (int d0 = 0; d0 < 4; ++d0) s = __builtin_amdgcn_mfma_f32_32x32x16_bf16(kf[d0], qf[d0], s, 0, 0, 0);
    return s;
}
struct TileRegs { u32x4 k[4], v[4]; };
template <class KRow, class VRow> __device__ __forceinline__ void load_tile(TileRegs& t, KRow krow, VRow vrow, int lane) {
#pragma unroll
    for (int j = 0; j < 4; ++j) { const int r = 8 * j + (lane >> 3); t.k[j] = *(const u32x4*)(krow(r) + (lane & 7) * 8); t.v[j] = *(const u32x4*)(vrow(r) + (lane & 7) * 8); }
}
__device__ __forceinline__ void stage_tile(ATT_LAS unsigned char* st, const TileRegs& t, int lane) {
#pragma unroll
    for (int j = 0; j < 4; ++j) { const int r = 8 * j + (lane >> 3);
        *(ATT_LAS u32x4*)(st + r * KSTRIDE + (lane & 7) * 16) = t.k[j]; *(ATT_LAS u32x4*)(st + KSTAGE + r * VSTRIDE + (lane & 7) * 16) = t.v[j]; }
}
__device__ __forceinline__ void read_kfrag(bf16x8 (&kf)[4], ATT_LAS const unsigned char* st, int lane) {
    ATT_LAS const unsigned char* p = st + (lane & 31) * KSTRIDE + (lane >> 5) * 16;
#pragma unroll
    for (int d0 = 0; d0 < 4; ++d0) kf[d0] = *(ATT_LAS const bf16x8*)(p + d0 * 32);
}
typedef short v4i16_t __attribute__((ext_vector_type(4)));
__device__ __forceinline__ s16x4 vtr(ATT_LAS const unsigned char* p) { return __builtin_bit_cast(s16x4, __builtin_amdgcn_ds_read_tr16_b64_v4i16((ATT_LAS v4i16_t*)p)); }
__device__ __forceinline__ void read_vfrag(bf16x8 (&vf)[2][2], ATT_LAS const unsigned char* vb) {
#pragma unroll
    for (int s = 0; s < 2; ++s)
#pragma unroll
        for (int d0 = 0; d0 < 2; ++d0) { const s16x4 lo = vtr(vb + (16 * s) * VSTRIDE + 64 * d0), hi = vtr(vb + (16 * s + 8) * VSTRIDE + 64 * d0);
            vf[s][d0] = (bf16x8){lo[0], lo[1], lo[2], lo[3], hi[0], hi[1], hi[2], hi[3]}; }
}
__device__ __forceinline__ void pv_mma(f32x16 (&o)[2], const bf16x8 (&vf)[2][2], const bf16x8 (&pw)[2]) {
#pragma unroll
    for (int s = 0; s < 2; ++s)
#pragma unroll
        for (int d0 = 0; d0 < 2; ++d0) o[d0] = __builtin_amdgcn_mfma_f32_32x32x16_bf16(vf[s][d0], pw[s], o[d0], 0, 0, 0);
}
__device__ __forceinline__ float swap32(float x) { const auto rr = __builtin_amdgcn_permlane32_swap(__float_as_uint(x), __float_as_uint(x), false, false); return __uint_as_float((__builtin_amdgcn_mbcnt_hi(~0u, __builtin_amdgcn_mbcnt_lo(~0u, 0u)) < 32u) ? rr[1] : rr[0]); }
__device__ __forceinline__ void pack_p(bf16x8 (&pw)[2], const f32x16& p) {
#pragma unroll
    for (int s = 0; s < 2; ++s) { u32x4 w; w.x = cvtpk(p[8 * s], p[8 * s + 1]); w.y = cvtpk(p[8 * s + 2], p[8 * s + 3]); w.z = cvtpk(p[8 * s + 4], p[8 * s + 5]); w.w = cvtpk(p[8 * s + 6], p[8 * s + 7]);
        pw[s] = __builtin_bit_cast(bf16x8, w); }
}
__device__ __forceinline__ void softmax_step(f32x16& p, float& m, float& zl, f32x16 (&o)[2]) {
    float tm = fmaxf(fmaxf(p[0], p[1]), fmaxf(p[2], p[3]));
#pragma unroll
    for (int r = 4; r < 16; r += 4) tm = fmaxf(tm, fmaxf(fmaxf(p[r], p[r + 1]), fmaxf(p[r + 2], p[r + 3])));
    { const auto rr = __builtin_amdgcn_permlane32_swap(__float_as_uint(tm), __float_as_uint(tm), false, false); tm = fmaxf(__uint_as_float(rr[0]), __uint_as_float(rr[1])); }
    const float mn = fmaxf(m, tm), al = __builtin_amdgcn_exp2f(m - mn); m = mn;
    float s = 0.f;
#pragma unroll
    for (int r = 0; r < 16; ++r) { p[r] = __builtin_amdgcn_exp2f(p[r] - mn); s += p[r]; }
    zl = zl * al + s;
#pragma unroll
    for (int d0 = 0; d0 < 2; ++d0)
#pragma unroll
        for (int r = 0; r < 16; ++r) o[d0][r] *= al;
}
__device__ __forceinline__ void store_o(const f32x16 (&o)[2], float scale, bf16_t* orow, int hi) {
#pragma unroll
    for (int d0 = 0; d0 < 2; ++d0)
#pragma unroll
        for (int g = 0; g < 4; ++g) { u32x2 w; w.x = cvtpk(o[d0][4 * g] * scale, o[d0][4 * g + 1] * scale); w.y = cvtpk(o[d0][4 * g + 2] * scale, o[d0][4 * g + 3] * scale);
            *(u32x2*)(orow + 32 * d0 + 8 * g + 4 * hi) = w; }
}

template <bool DRY = false> __device__ __forceinline__ void sb_unit(int id, const bf16_t* QKV, bf16_t* OC, ATT_LAS unsigned char* vst, int lane) {
    asm volatile("" : "+v"(lane));
    const int bh = id >> 8, qt = id & 255, b = bh / 6, h = bh - 6 * b, t0 = qt * 32, i = lane & 31, hi = lane >> 5;
    const size_t HS = (size_t)M * 64;
    const bf16_t* base = QKV + (size_t)h * HS + (size_t)b * S * 64;
    bf16x8 qf[4]; load_frag4(qf, base + (size_t)(t0 + i) * 64, hi);
    f32x16 o[2];
#pragma unroll
    for (int r = 0; r < 16; ++r) { o[0][r] = 0.f; o[1][r] = 0.f; }
    ATT_LAS const unsigned char* vb = vst + KSTAGE + (4 * hi + ((lane & 15) >> 2)) * VSTRIDE + ((lane >> 4) & 1) * 32 + (lane & 3) * 8;
    float c = 0.f;
#define SB_LOAD(T_, k_) load_tile(T_, [&](int r) { return base + 6 * HS + (size_t)((k_) + r) * 64; }, [&](int r) { return base + 12 * HS + (size_t)((k_) + r) * 64; }, lane)
    auto tile = [&](const int k0, TileRegs& tr, const int knext) __attribute__((always_inline)) -> bool {
        asm volatile("s_waitcnt lgkmcnt(0)" ::: "memory");
        stage_tile(vst, tr, lane);
        if (knext >= 0 && !DRY) SB_LOAD(tr, knext);
        asm volatile("s_waitcnt lgkmcnt(0)" ::: "memory");
        bf16x8 kf[4], vf[2][2]; read_kfrag(kf, vst, lane); read_vfrag(vf, vb);
        f32x16 z = qk_tile(kf, qf);
        float w[16];
        const bool diag = (k0 == t0);
#pragma unroll
        for (int r = 0; r < 16; ++r) { const float zz = z[r], e = __builtin_amdgcn_exp2f(-fabsf(zz)), l2 = __builtin_amdgcn_logf(1.0f + e);
            w[r] = fmaxf(zz, 0.f) + l2; z[r] = fminf(zz, 0.f) - l2; }
        if (diag) { int ii = i - 4 * hi; asm volatile("" : "+v"(ii));
#pragma unroll
            for (int r = 0; r < 16; ++r) if (!((r & 3) + 8 * (r >> 2) < ii)) { w[r] = 0.f; z[r] = NEG; } }
        float a[16], T[4], Tp[4];
#pragma unroll
        for (int g = 0; g < 4; ++g) { a[4 * g + 3] = 0.f; a[4 * g + 2] = w[4 * g + 3]; a[4 * g + 1] = a[4 * g + 2] + w[4 * g + 2]; a[4 * g] = a[4 * g + 1] + w[4 * g + 1]; T[g] = a[4 * g] + w[4 * g]; }
#pragma unroll
        for (int g = 0; g < 4; ++g) { const auto rr = __builtin_amdgcn_permlane32_swap(__float_as_uint(T[g]), __float_as_uint(T[g]), false, false); Tp[g] = __uint_as_float(hi == 0 ? rr[1] : rr[0]); }
        const float p3 = T[3] + Tp[3], p2 = T[2] + Tp[2], p1 = T[1] + Tp[1], p0 = T[0] + Tp[0];
        float cum[4]; cum[3] = 0.f; cum[2] = p3; cum[1] = p3 + p2; cum[0] = cum[1] + p1; const float total = cum[0] + p0;
        f32x16 p;
#pragma unroll
        for (int g = 0; g < 4; ++g) { const float bg = c - cum[g] - (hi == 0 ? Tp[g] : 0.f);
#pragma unroll
            for (int j = 0; j < 4; ++j) p[4 * g + j] = __builtin_amdgcn_exp2f(z[4 * g + j] + (bg - a[4 * g + j])); }
        c -= total;
        bf16x8 pw[2]; pack_p(pw, p);
        pv_mma(o, vf, pw);
        return k0 < 32 || __all(c < -150.0f);
    };
    TileRegs ta, tb;
    SB_LOAD(ta, t0); if (t0 >= 32) SB_LOAD(tb, t0 - 32);
#pragma unroll 1
    for (int k0 = t0; ; k0 -= 64) {
        if (tile(k0, ta, k0 - 64)) break;
        if (tile(k0 - 32, tb, k0 - 96)) break;
    }
#undef SB_LOAD
    store_o(o, 1.0f, OC + (size_t)(DRY ? ((b * S + t0 + i) & 4095) : (b * S + t0 + i)) * NOC + h * 64, hi);
}

__device__ __forceinline__ void dil_tile(int T, int& g, int& kt) { if (T < 5) { g = 2; kt = T; } else if (T < 13) { g = 1; kt = T - 5; } else { g = 0; kt = T - 13; } }
template <bool DRY = false> __device__ __forceinline__ void dil_unit(int id, const bf16_t* QKV, bf16_t* OC, ATT_LAS const float* tbl, ATT_LAS unsigned char* vst, int lane) {
    asm volatile("" : "+v"(lane));
    const int b = id >> 9, hh = (id >> 8) & 1, blk = (id >> 4) & 15, res = id & 15, i = lane & 31, hi = lane >> 5;
    const int tb = 512 * blk + res, tq = tb + 16 * i;
    const size_t HS = (size_t)M * 64;
    const bf16_t* base = QKV + (size_t)b * S * 64;
    f32x16 o[2];
#pragma unroll
    for (int r = 0; r < 16; ++r) { o[0][r] = 0.f; o[1][r] = 0.f; }
    ATT_LAS const unsigned char* vb = vst + KSTAGE + (4 * hi + ((lane & 15) >> 2)) * VSTRIDE + ((lane >> 4) & 1) * 32 + (lane & 3) * 8;
    float m = NEG, zl = 0.f;
    bf16x8 qf[4];
#define DIL_LOAD(R_, T_) do { int g_, kt_; dil_tile((T_), g_, kt_); const int sh_ = 2 * g_, hd_ = 2 * g_ + hh, rg_ = tb & ((1 << sh_) - 1), Jt_ = (tb >> sh_) - 128 + 32 * kt_, Jm_ = (S >> sh_) - 1; \
        auto krow_ = [&](int r) { int J_ = Jt_ + r; J_ = J_ < 0 ? 0 : J_; J_ = J_ > Jm_ ? Jm_ : J_; return base + (size_t)(24 + hd_) * HS + (size_t)(rg_ + (J_ << sh_)) * 64; }; \
        load_tile(R_, krow_, [&](int r) { return krow_(r) + 6 * HS; }, lane); } while (0)
    int gprev = -1;
    auto tile = [&](const int T, TileRegs& tr) __attribute__((always_inline)) {
        int g, kt; dil_tile(T, g, kt);
        const int sh = 2 * g, sq = 16 >> sh, Jt0 = (tb >> sh) - 128 + 32 * kt;
        if (g != gprev) { load_frag4(qf, base + (size_t)(18 + 2 * g + hh) * HS + (size_t)tq * 64, hi); gprev = g; }
        const bool skip = Jt0 + 31 < 0;
        asm volatile("s_waitcnt lgkmcnt(0)" ::: "memory");
        if (!skip) stage_tile(vst, tr, lane);
        if (T + 2 < 33 && !DRY) DIL_LOAD(tr, T + 2);
        if (skip) return;
        ATT_LAS const float* tb_g = tbl + (g * 2 + hh) * TBLN + 1;
        asm volatile("s_waitcnt lgkmcnt(0)" ::: "memory");
        bf16x8 kf[4], vf[2][2]; read_kfrag(kf, vst, lane); read_vfrag(vf, vb);
        f32x16 p = qk_tile(kf, qf);
        const int c0 = sq * i + 128 - 32 * kt - 4 * hi;
#pragma unroll
        for (int r = 0; r < 16; ++r) { const int kk = (r & 3) + 8 * (r >> 2); int idx = c0 - kk; idx = idx < -1 ? -1 : idx; idx = idx > 129 ? 129 : idx;
            float bv = tb_g[idx]; if (Jt0 + 4 * hi + kk < 0) bv = NEG; p[r] += bv; }
        softmax_step(p, m, zl, o);
        bf16x8 pw[2]; pack_p(pw, p);
        pv_mma(o, vf, pw);
    };
    TileRegs ta, tbq;
    DIL_LOAD(ta, 0); DIL_LOAD(tbq, 1);
#pragma unroll 1
    for (int T = 0; T < 33; T += 2) {
        tile(T, ta);
        if (T + 1 < 33) tile(T + 1, tbq);
    }
#undef DIL_LOAD
    float Z; { const auto rr = __builtin_amdgcn_permlane32_swap(__float_as_uint(zl), __float_as_uint(zl), false, false); Z = __uint_as_float(rr[0]) + __uint_as_float(rr[1]); }
    store_o(o, 1.0f / Z, OC + (size_t)(DRY ? ((b * S + tq) & 4095) : (b * S + tq)) * NOC + 384 + hh * 64, hi);
}

__device__ __forceinline__ void mem_unit(int id, const bf16_t* QKV, const bf16_t* MK, const bf16_t* MV, bf16_t* OC, ATT_LAS unsigned char* vst, int lane) {
    asm volatile("" : "+v"(lane));
    const int b = id >> 10, head = (id >> 8) & 3, qt = id & 255, t0 = qt * 32, i = lane & 31, hi = lane >> 5;
    bf16x8 qf[4]; load_frag4(qf, QKV + ((size_t)(36 + head) * M + (b * S + t0 + i)) * 64, hi);
    f32x16 o[2];
#pragma unroll
    for (int r = 0; r < 16; ++r) { o[0][r] = 0.f; o[1][r] = 0.f; }
    ATT_LAS const unsigned char* vb = vst + KSTAGE + (4 * hi + ((lane & 15) >> 2)) * VSTRIDE + ((lane >> 4) & 1) * 32 + (lane & 3) * 8;
    float m = NEG, zl = 0.f;
    const bf16_t* kb = MK + (size_t)(b * NMEM) * 256 + head * 64; const bf16_t* vbs = MV + (size_t)(b * NMEM) * 256 + head * 64;
    TileRegs tn;
    load_tile(tn, [&](int r) { return kb + (size_t)r * 256; }, [&](int r) { return vbs + (size_t)r * 256; }, lane);
#pragma unroll 1
    for (int kt = 0; kt < 8; ++kt) {
        const TileRegs tc = tn;
        if (kt + 1 < 8) { const int mn = 32 * (kt + 1); load_tile(tn, [&](int r) { return kb + (size_t)(mn + r) * 256; }, [&](int r) { return vbs + (size_t)(mn + r) * 256; }, lane); }
        asm volatile("s_waitcnt lgkmcnt(0)" ::: "memory");
        stage_tile(vst, tc, lane);
        asm volatile("s_waitcnt lgkmcnt(0)" ::: "memory");
        bf16x8 kf[4], vf[2][2]; read_kfrag(kf, vst, lane); read_vfrag(vf, vb);
        f32x16 p = qk_tile(kf, qf);
        softmax_step(p, m, zl, o);
        bf16x8 pw[2]; pack_p(pw, p);
        pv_mma(o, vf, pw);
    }
    float Z; { const auto rr = __builtin_amdgcn_permlane32_swap(__float_as_uint(zl), __float_as_uint(zl), false, false); Z = __uint_as_float(rr[0]) + __uint_as_float(rr[1]); }
    store_o(o, 1.0f / Z, OC + (size_t)(b * S + t0 + i) * NOC + 512 + head * 64, hi);
}
}

constexpr int RING_OFF = 0, RING_BYTES = 131072;
constexpr int LDSCTL_OFF = RING_BYTES, MISC_OFF = LDSCTL_OFF + 320;
constexpr int LDS_BYTES = 147456;
static_assert(att::LDS_BYTES <= RING_BYTES && pg8::STAGE_BYTES <= RING_BYTES && MISC_OFF + 128 <= LDS_BYTES, "LDS map");
#define GAS __attribute__((address_space(1)))
#define LAS __attribute__((address_space(3)))
typedef unsigned v4u __attribute__((ext_vector_type(4)));
typedef float f32x4 __attribute__((ext_vector_type(4)));
typedef GAS unsigned gu32;
#define LDS_WAIT() asm volatile("s_waitcnt lgkmcnt(0)" ::: "memory")
constexpr int CW_BAR = 4096;
#define XB_TMO      128
#define XB_XCNT(j)  (256  + 64 * (j))
#define XB_XSUB(j)  (1280 + 64 * (j))
#define XB_XGEN(j)  (2304 + 64 * (j))
#define XB_TOP      3328
#define XB_TOPGEN   3392
#define XCD_BAR_WORDS 3456
#define XB_SPIN_CAP (1u << 18)

__device__ __forceinline__ unsigned xb_ld(unsigned* p)              { return __hip_atomic_load(p, __ATOMIC_RELAXED, __HIP_MEMORY_SCOPE_AGENT); }
__device__ __forceinline__ unsigned xb_add(unsigned* p, unsigned v) { return __hip_atomic_fetch_add(p, v, __ATOMIC_RELAXED, __HIP_MEMORY_SCOPE_AGENT); }
__device__ __forceinline__ unsigned xb_xcc_id() { return (unsigned)__builtin_amdgcn_s_getreg((3 << 11) | 20) & 0xFu; }
#define XB_SPIN(cond, bar) do { unsigned _sp = 0; while (cond) { __builtin_amdgcn_s_sleep(1); \
    if ((++_sp & 255u) == 0u) { if (xb_ld(&(bar)[XB_TMO])) break; if (_sp > XB_SPIN_CAP) { atomicAdd(&(bar)[XB_TMO], 1u); break; } } } } while (0)

struct XcdBarrier {
    int wave; unsigned* bar; unsigned x;
    volatile LAS unsigned* st;
};

__device__ __forceinline__ bool xb_thread0(int wave) { int ln; asm volatile("v_mbcnt_lo_u32_b32 %0, -1, 0\n\tv_mbcnt_hi_u32_b32 %0, -1, %0" : "=v"(ln)); return ln == 0 && wave == 0; }
__device__ __forceinline__ XcdBarrier xcd_barrier_post(unsigned* bar, volatile LAS unsigned* st, int wave) {
    XcdBarrier b; b.wave = wave; b.bar = bar; b.x = xb_xcc_id(); b.st = st;
    if (xb_thread0(wave)) (void)xb_add(&bar[XB_XCNT(b.x)], 1u);
    return b;
}
__device__ __forceinline__ void xcd_barrier_complete(unsigned* bar, unsigned x, unsigned& nloc, unsigned& nx) {
    const unsigned G = gridDim.x * gridDim.y * gridDim.z;
    unsigned sum, cnt, mine, sp = 0u;
    for (;;) {
        sum = 0u; cnt = 0u; mine = 0u;
#pragma unroll
        for (unsigned j = 0; j < 16; ++j) { const unsigned c = xb_ld(&bar[XB_XCNT(j)]); sum += c; cnt += (c > 0u) ? 1u : 0u; mine = (j == x) ? c : mine; }
        if (sum == G) break;
        __builtin_amdgcn_s_sleep(1);
        if ((++sp & 255u) == 0u) { if (xb_ld(&bar[XB_TMO])) break; if (sp > XB_SPIN_CAP) { atomicAdd(&bar[XB_TMO], 1u); break; } }
    }
    nloc = mine > 0u ? mine : 1u; nx = cnt > 0u ? cnt : 1u;
}

__device__ __forceinline__ void xcd_barrier(const XcdBarrier& b) {
    asm volatile("s_waitcnt vmcnt(0)" ::: "memory");
    __syncthreads();
    if (xb_thread0(b.wave)) {
        unsigned* bar = b.bar;
        __builtin_amdgcn_s_waitcnt(0);
        unsigned nloc = b.st[0], nx = b.st[1];
        if (nloc == 0u) { xcd_barrier_complete(bar, b.x, nloc, nx); b.st[0] = nloc; b.st[1] = nx; }
        const unsigned old = xb_add(&bar[XB_XSUB(b.x)], 1u);
        const unsigned gen = old / nloc;
        if (old + 1u == (gen + 1u) * nloc) {
            __builtin_amdgcn_fence(__ATOMIC_RELEASE, "agent");
            asm volatile("s_waitcnt vmcnt(0)" ::: "memory");
            const unsigned og = xb_add(&bar[XB_TOP], 1u);
            const unsigned tg = og / nx;
            if (og + 1u == (tg + 1u) * nx) xb_add(&bar[XB_TOPGEN], 1u);
            else XB_SPIN(xb_ld(&bar[XB_TOPGEN]) == tg, bar);
            __builtin_amdgcn_fence(__ATOMIC_ACQUIRE, "agent");
            xb_add(&bar[XB_XGEN(b.x)], 1u);
            asm volatile("s_waitcnt vmcnt(0)" ::: "memory");
        } else {
            XB_SPIN(xb_ld(&bar[XB_XGEN(b.x)]) == gen, bar);
            __builtin_amdgcn_fence(__ATOMIC_ACQUIRE, "agent");
            asm volatile("s_waitcnt vmcnt(0)" ::: "memory");
        }
    }
    __syncthreads();

}

struct Frame {
    LAS unsigned char* lds;
    volatile LAS unsigned* MISC;
    gu32* ctl;
    int wave, vcu, G;
};
__device__ __forceinline__ int lane_now() { int ln; asm volatile("v_mbcnt_lo_u32_b32 %0, -1, 0\n\tv_mbcnt_hi_u32_b32 %0, -1, %0" : "=v"(ln)); return ln; }

__device__ __forceinline__ unsigned pk2(float lo, float hi) { return (unsigned)f2bf(lo) | ((unsigned)f2bf(hi) << 16); }
__device__ __forceinline__ int dest_row(int kind, int n0) {
    if (kind == 1) return n0 < FF ? (n0 >> 7) * 256 + (n0 & 127) : ((n0 - FF) >> 7) * 256 + 128 + ((n0 - FF) & 127);
    if (kind == 2) return (n0 & ~255) + (((n0 >> 5) & 1) << 7) + (((n0 >> 6) & 3) << 5);
    return n0;
}
__device__ __forceinline__ void p0_item_load(float (&v)[32], const float* W, const float* gain, int N, int item, int lane) {
    const int nblk = N / 32, kb = item / nblk, nb = item % nblk, k0 = 64 * kb, n0 = 32 * nb;
#pragma unroll
    for (int i = 0; i < 32; ++i) { const int kk = 2 * i + (lane >> 5); const float g = gain ? gain[k0 + kk] : 1.0f; v[i] = W[(size_t)(k0 + kk) * N + n0 + (lane & 31)] * g; }
}
__device__ __forceinline__ void p0_item_finish(const float (&v)[32], int N, bf16_t* WT, int kind, int ldk, int koff, LAS float* scr, int item, int lane) {
    const int nblk = N / 32, kb = item / nblk, nb = item % nblk, k0 = 64 * kb, n0 = 32 * nb;
#pragma unroll
    for (int i = 0; i < 32; ++i) scr[(2 * i + (lane >> 5)) * 33 + (lane & 31)] = v[i];
    LDS_WAIT(); asm volatile("" ::: "memory");
    const int c = lane & 7, r0 = dest_row(kind, n0);
#pragma unroll
    for (int j = 0; j < 4; ++j) { const int n = (lane >> 3) + 8 * j; const LAS float* s = scr + (8 * c) * 33 + n;
        v4u o; o.x = pk2(s[0 * 33], s[1 * 33]); o.y = pk2(s[2 * 33], s[3 * 33]); o.z = pk2(s[4 * 33], s[5 * 33]); o.w = pk2(s[6 * 33], s[7 * 33]);
        *(GAS v4u*)(WT + (size_t)(r0 + n) * ldk + koff + k0 + 8 * c) = o; }
    LDS_WAIT(); asm volatile("" ::: "memory");
}
__device__ __forceinline__ float wave_sum(float v) {
#pragma unroll
    for (int o = 1; o < 64; o <<= 1) v += __shfl_xor(v, o);
    return v;
}
__device__ __forceinline__ void p0_row(const float* xrow, bf16_t* orow, float* rstd, int lane) {
    const GAS f32x4* xr = (const GAS f32x4*)xrow + lane;
    f32x4 v[4]; float s = 0.f;
#pragma unroll
    for (int j = 0; j < 4; ++j) { v[j] = xr[64 * j]; s += (v[j].x * v[j].x + v[j].y * v[j].y) + (v[j].z * v[j].z + v[j].w * v[j].w); }
    s = wave_sum(s);
    GAS unsigned long long* o8 = (GAS unsigned long long*)orow + lane;
#pragma unroll
    for (int j = 0; j < 4; ++j) o8[64 * j] = (unsigned long long)pk2(v[j].x, v[j].y) | ((unsigned long long)pk2(v[j].z, v[j].w) << 32);
    if (lane == 0) *rstd = 1.0f / sqrtf(s * (1.0f / D) + EPS);
}
#ifndef USE_FOLD
#define USE_FOLD 0
#endif
#ifndef P4_REP_DIL
#define P4_REP_DIL 0
#endif
#ifndef P4_REP_MEM
#define P4_REP_MEM 0
#endif
#ifndef P4_REP_SB
#define P4_REP_SB 0
#endif
#ifndef P5_REP
#define P5_REP 0
#endif
#ifndef P0_REP_T
#define P0_REP_T 0
#endif
#ifndef P0_REP_R
#define P0_REP_R 0
#endif
struct WItem { const float* W; const float* gain; bf16_t* WT; int K, N, kind, ldk, koff; };
__device__ __forceinline__ void p0_prologue(Frame& F, const Ptrs& P) {
    unsigned char* ws = P.ws; const int lane_ = lane_now(), tid_ = F.wave * 64 + lane_;
    for (int u = F.vcu; u < 256; u += F.G) {
        const int rg = u >> 3, hd = u & 7, head = hd & 3, r0 = rg * 32, kb = 128 * F.wave;
        LAS float* sx = (LAS float*)(F.lds + F.wave * 16384);
        LAS float* part = (LAS float*)(F.lds + F.wave * 16384);
        const f32x4 gn = ((const GAS f32x4*)(P.mem_norm + kb))[lane_ & 31];
        float sq[16];
#pragma unroll
        for (int j = 0; j < 16; ++j) { const int r = 2 * j + (lane_ >> 5); const f32x4 v = ((const GAS f32x4*)(P.mem + (size_t)(r0 + r) * D + kb))[lane_ & 31];
            sq[j] = (v.x * v.x + v.y * v.y) + (v.z * v.z + v.w * v.w); *(LAS f32x4*)(sx + r * 128 + 4 * (lane_ & 31)) = v * gn; }
#pragma unroll
        for (int j = 0; j < 16; ++j) { float s = sq[j]; s += __shfl_xor(s, 1); s += __shfl_xor(s, 2); s += __shfl_xor(s, 4); s += __shfl_xor(s, 8); s += __shfl_xor(s, 16); sq[j] = s; }
        LDS_WAIT(); asm volatile("" ::: "memory");
        float av[32];
#pragma unroll
        for (int r = 0; r < 32; ++r) av[r] = 0.f;
        const float* wp = P.w_mem_kv + (size_t)kb * 512 + hd * 64 + lane_;
#pragma unroll 4
        for (int k = 0; k < 128; k += 4) { float w[4];
#pragma unroll
            for (int i = 0; i < 4; ++i) w[i] = wp[(size_t)(k + i) * 512];
#pragma unroll
            for (int r = 0; r < 32; ++r) { const f32x4 a = *(const LAS f32x4*)(sx + r * 128 + k); av[r] += (a.x * w[0] + a.y * w[1]) + (a.z * w[2] + a.w * w[3]); } }
        LDS_WAIT(); asm volatile("" ::: "memory");
#pragma unroll
        for (int r = 0; r < 32; ++r) part[r * 64 + lane_] = av[r];
#pragma unroll
        for (int j = 0; j < 16; ++j) if ((lane_ & 31) == 0) part[2048 + 2 * j + (lane_ >> 5)] = sq[j];
        __syncthreads();
        float fv[4], rs[4];
#pragma unroll
        for (int r = 0; r < 4; ++r) { const int row = 4 * F.wave + r; float s = 0.f, q = 0.f;
#pragma unroll
            for (int w8 = 0; w8 < 8; ++w8) { const LAS float* pp = (const LAS float*)(F.lds + w8 * 16384); s += pp[row * 64 + lane_]; q += pp[2048 + row]; }
            rs[r] = 1.0f / sqrtf(q * (1.0f / D) + EPS); fv[r] = s * rs[r]; }
        const int row0 = r0 + 4 * F.wave, b = row0 / NMEM, mi = row0 % NMEM;
        if (hd < 4) {
#pragma unroll
            for (int r = 0; r < 4; ++r) { const float q = wave_sum(fv[r] * fv[r]); ((bf16_t*)(ws + WS_MK))[(size_t)(row0 + r) * 256 + head * 64 + lane_] = f2bf(fv[r] / sqrtf(q * (1.0f / HD) + EPS) * P.x_k_gain[lane_]); }
        } else {
#pragma unroll
            for (int r = 0; r < 4; ++r) ((bf16_t*)(ws + WS_MVT))[(size_t)(row0 + r) * 256 + head * 64 + lane_] = f2bf(fv[r]);
        }
        __syncthreads();
    }
    if (F.vcu == 0 && tid_ < 129) { float* BIAS = (float*)(ws + WS_BIAS);
        for (int g = 0; g < 3; ++g) for (int hh = 0; hh < 2; ++hh) BIAS[(g * 2 + hh) * 129 + tid_] = P.rel_bias[T5B[g][tid_] * 6 + g * 2 + hh] * LOG2E; }
    LAS float* scr = (LAS float*)(F.lds + F.wave * 16384);
    const int gw = F.vcu * 8 + F.wave, NGW = F.G * 8;
    const WItem items[9] = {
        {P.ffn1_w_gu, P.ffn1_norm, (bf16_t*)(ws + WS_WGU1), D, NGU, 1, D, 0}, {P.w_in, P.mix_norm, (bf16_t*)(ws + WS_WIN), D, INCOLS, 2, D, 0}, {P.ffn2_w_gu, P.ffn2_norm, (bf16_t*)(ws + WS_WGU2), D, NGU, 1, D, 0},
        {P.ffn1_w_down, nullptr, (bf16_t*)(ws + WS_WD1), FF, D, 0, FF, 0}, {P.ffn2_w_down, nullptr, (bf16_t*)(ws + WS_WD2), FF, D, 0, FF, 0}, {P.w_out, nullptr, (bf16_t*)(ws + WS_WOUT), D, D, 0, D, 0},
        {P.w_br_sb, nullptr, (bf16_t*)(ws + WS_WSB2), 384, D, 0, 384, 0}, {P.w_br_dil, nullptr, (bf16_t*)(ws + WS_WDIL), 128, D, 0, 128, 0}, {P.w_br_x, nullptr, (bf16_t*)(ws + WS_WX), 256, D, 0, 256, 0}};
    {
        int cum[10]; cum[0] = 0;
#pragma unroll
        for (int w = 0; w < 9; ++w) cum[w + 1] = cum[w] + (items[w].K / 64) * (items[w].N / 32);
        const int total = cum[9];
        float va[32], vb[32];
#define P0_LOCATE(G_, w_) int w_ = 0; _Pragma("unroll") for (int q_ = 1; q_ < 9; ++q_) w_ += ((G_) >= cum[q_]) ? 1 : 0
#define P0_LOAD(V_, G_) do { P0_LOCATE(G_, w__); const float* W__ = items[0].W; const float* g__ = items[0].gain; int N__ = items[0].N, c__ = 0; \
            _Pragma("unroll") for (int q_ = 1; q_ < 9; ++q_) if (w__ == q_) { W__ = items[q_].W; g__ = items[q_].gain; N__ = items[q_].N; c__ = cum[q_]; } \
            p0_item_load(V_, W__, g__, N__, (G_) - c__, lane_); } while (0)
#define P0_FINISH(V_, G_) do { P0_LOCATE(G_, w__); bf16_t* T__ = items[0].WT; int N__ = items[0].N, k__ = items[0].kind, l__ = items[0].ldk, o__ = items[0].koff, c__ = 0; \
            _Pragma("unroll") for (int q_ = 1; q_ < 9; ++q_) if (w__ == q_) { T__ = items[q_].WT; N__ = items[q_].N; k__ = items[q_].kind; l__ = items[q_].ldk; o__ = items[q_].koff; c__ = cum[q_]; } \
            p0_item_finish(V_, N__, T__, k__, l__, o__, scr, (G_) - c__, lane_); } while (0)
        int G = gw;
        if (G < total) P0_LOAD(va, G);
        for (; G < total; G += 2 * NGW) {
            if (G + NGW < total) P0_LOAD(vb, G + NGW);
            P0_FINISH(va, G);
            if (G + NGW < total) { if (G + 2 * NGW < total) P0_LOAD(va, G + 2 * NGW); P0_FINISH(vb, G + NGW); }
        }
#undef P0_LOCATE
#undef P0_LOAD
#undef P0_FINISH
    }
    for (int m = gw; m < M; m += 4 * NGW) {
        f32x4 v[4][4];
#pragma unroll
        for (int q = 0; q < 4; ++q) { const int mq = (m + q * NGW < M) ? m + q * NGW : m; const GAS f32x4* xr = (const GAS f32x4*)(P.x + (size_t)mq * D) + lane_;
#pragma unroll
            for (int j = 0; j < 4; ++j) v[q][j] = xr[64 * j]; }
#pragma unroll
        for (int q = 0; q < 4; ++q) { const int mq = m + q * NGW; if (mq < M) { float s = 0.f;
#pragma unroll
            for (int j = 0; j < 4; ++j) s += (v[q][j].x * v[q][j].x + v[q][j].y * v[q][j].y) + (v[q][j].z * v[q][j].z + v[q][j].w * v[q][j].w);
            s = wave_sum(s);
            GAS unsigned long long* o8 = (GAS unsigned long long*)((bf16_t*)(ws + WS_XB) + (size_t)mq * D) + lane_;
#pragma unroll
            for (int j = 0; j < 4; ++j) o8[64 * j] = (unsigned long long)pk2(v[q][j].x, v[q][j].y) | ((unsigned long long)pk2(v[q][j].z, v[q][j].w) << 32);
            if (lane_ == 0) ((float*)(ws + WS_RSTD0))[mq] = 1.0f / sqrtf(s * (1.0f / D) + EPS); } }
    }
}

#ifndef REP_MASK
#define REP_MASK 0x0
#endif
constexpr int NPHASE = 9;
struct Args { Ptrs P; int ph_lo, ph_hi, use_bar, rep; };
__global__ void __launch_bounds__(512, 2) mega_fwd(Args args) {
    extern __shared__ __attribute__((aligned(16))) unsigned char lds[];
    Frame F;
    F.lds = (LAS unsigned char*)lds;
    F.MISC = (volatile LAS unsigned*)(F.lds + MISC_OFF);
    F.wave = __builtin_amdgcn_readfirstlane(threadIdx.x >> 6);
    F.G = gridDim.x; { const int bx = blockIdx.x; F.vcu = (F.G % 8 == 0) ? (bx % 8) * (F.G / 8) + bx / 8 : bx; }
    const Ptrs& P = args.P;
    unsigned char* ws = P.ws;
    F.ctl = (gu32*)(ws + WS_CTL);
    for (int u = F.wave * 64 + lane_now(); u < (LDS_BYTES - LDSCTL_OFF) / 4; u += 512) ((LAS unsigned*)(F.lds + LDSCTL_OFF))[u] = 0u;
    __syncthreads();
    XcdBarrier bar; bar.wave = F.wave; bar.bar = (unsigned*)(F.ctl + CW_BAR); bar.x = 0; bar.st = nullptr;
    if (args.use_bar) bar = xcd_barrier_post((unsigned*)(F.ctl + CW_BAR), F.MISC + 8, F.wave);
    const int lo = args.ph_lo, hi = args.ph_hi;
#define IN(k) (lo <= (k) && (k) < hi)
#define SEAM(k) do { if (IN(k) && IN((k) + 1)) xcd_barrier(bar); } while (0)
    bf16_t *XB = (bf16_t*)(ws + WS_XB), *OC = (bf16_t*)P.out  , *H = (bf16_t*)(ws + WS_BIG), *QKV = H; unsigned char* G = ws + WS_G;
    bf16_t* MERGED = (bf16_t*)(ws + WS_BIG + 64 * MiB);
    bf16_t* MACC = (bf16_t*)(ws + WS_BIG); float *SS1 = (float*)(ws + WS_SS1), *SS2 = (float*)(ws + WS_SS2), *RSTD0 = (float*)(ws + WS_RSTD0);
    const int cblk = (int)blockIdx.x;

    _Pragma("unroll") for (int rp_ = 0; rp_ <= ((REP_MASK >> 0) & 1); ++rp_) if (IN(0)) { if (rp_) xcd_barrier(bar); p0_prologue(F, P); } SEAM(0);
    _Pragma("unroll") for (int rp_ = 0; rp_ <= ((REP_MASK >> 1) & 1); ++rp_) if (IN(1)) { if (rp_) xcd_barrier(bar); pg8::Gemm g{XB, (const bf16_t*)(ws + WS_WGU1), M, NGU, D, D}; pg8::StaticOrder So; So.init(M, NGU, F.G, cblk);
        pg8::EpiFfnUp E{H, RSTD0, nullptr}; pg8::gemm_phase(F.lds, g, So, E, F.wave); } SEAM(1);
    _Pragma("unroll") for (int rp_ = 0; rp_ <= ((REP_MASK >> 2) & 1); ++rp_) if (IN(2)) { if (rp_) xcd_barrier(bar); pg8::Gemm g{H, (const bf16_t*)(ws + WS_WD1), M, D, FF, FF}; pg8::StaticOrder So; So.init(M, D, F.G, cblk);
        pg8::EpiRes<true, false, true> E{nullptr, XB, nullptr, XB, SS1, 0.5f};   pg8::gemm_phase(F.lds, g, So, E, F.wave); } SEAM(2);
    _Pragma("unroll") for (int rp_ = 0; rp_ <= ((REP_MASK >> 3) & 1); ++rp_) if (IN(3)) { if (rp_) xcd_barrier(bar); pg8::Gemm g{XB, (const bf16_t*)(ws + WS_WIN), M, INCOLS, D, D}; pg8::StaticOrder So; So.init(M, INCOLS, F.G, cblk);
        pg8::EpiWin E{QKV, G, SS1, P.dil_q_gain, P.dil_k_gain, P.x_q_gain, nullptr, (bf16_t*)(ws + 57 * MiB)}; pg8::gemm_phase(F.lds, g, So, E, F.wave); } SEAM(3);
    _Pragma("unroll") for (int rp_ = 0; rp_ <= ((REP_MASK >> 4) & 1); ++rp_) if (IN(4)) { if (rp_) xcd_barrier(bar);
        LAS float* tbl = (LAS float*)(F.lds + att::LDS_TBL); const float* BIAS = (const float*)(ws + WS_BIAS); const int lane_ = lane_now();
        for (int e = F.wave * 64 + lane_; e < 6 * att::TBLN; e += 512) { const int t = e / att::TBLN, s = e % att::TBLN; tbl[e] = (s >= 1 && s <= 129) ? BIAS[t * 129 + s - 1] : att::NEG; }
        __syncthreads();
        LAS unsigned char* vst = F.lds + att::LDS_VST + F.wave * att::WSTAGE;
        const int gw = F.vcu * 8 + F.wave, NGW = F.G * 8;
        for (int id = gw; id < 2048; id += NGW) att::dil_unit(id, QKV, OC, tbl, vst, lane_);
#if P4_REP_DIL
        for (int id = gw; id < 2048; id += NGW) att::dil_unit<true>(id, QKV, (bf16_t*)(ws + 56 * MiB), tbl, vst, lane_);
#endif
        for (int rq_ = 0; rq_ <= P4_REP_MEM; ++rq_)
        for (int id = gw; id < 4096; id += NGW) att::mem_unit(id, QKV, (const bf16_t*)(ws + WS_MK), (const bf16_t*)(ws + WS_MVT), OC, vst, lane_);
        for (int id = gw; id < 6144; id += NGW) att::sb_unit(id, QKV, OC, vst, lane_);
#if P4_REP_SB
        for (int id = gw; id < 6144; id += NGW) att::sb_unit<true>(id, QKV, (bf16_t*)(ws + 56 * MiB), vst, lane_);
#endif
        asm volatile("s_waitcnt vmcnt(0) lgkmcnt(0)" ::: "memory"); __syncthreads();
    } SEAM(4);
    _Pragma("unroll") for (int rp_ = 0; rp_ <= ((REP_MASK >> 5) & 1); ++rp_) if (IN(5)) { if (rp_) xcd_barrier(bar); pg8::StaticOrder So; So.init(M, D, F.G, cblk);
        _Pragma("unroll") for (int r5_ = 0; r5_ <= P5_REP; ++r5_) {
          { pg8::Gemm g{OC, (const bf16_t*)(ws + WS_WSB2), M, D, 384, NOC}; pg8::EpiBranch<0> E{G, MACC, MERGED}; pg8::gemm_phase(F.lds, g, So, E, F.wave); }
          { pg8::Gemm g{OC + 384, (const bf16_t*)(ws + WS_WDIL), M, D, 128, NOC}; pg8::EpiBranch<1> E{G, MACC, MERGED}; pg8::gemm_phase(F.lds, g, So, E, F.wave); }
        }
        { pg8::Gemm g{OC + 512, (const bf16_t*)(ws + WS_WX), M, D, 256, NOC}; pg8::EpiBranch<2> E{G, MACC, MERGED}; pg8::gemm_phase(F.lds, g, So, E, F.wave); } } SEAM(5);
    _Pragma("unroll") for (int rp_ = 0; rp_ <= ((REP_MASK >> 6) & 1); ++rp_) if (IN(6)) { if (rp_) xcd_barrier(bar); pg8::Gemm g{MERGED, (const bf16_t*)(ws + WS_WOUT), M, D, D, D}; pg8::StaticOrder So; So.init(M, D, F.G, cblk);
        pg8::EpiRes<true, false, true> E{nullptr, XB, nullptr, XB, SS2, 1.0f}; pg8::gemm_phase(F.lds, g, So, E, F.wave); } SEAM(6);
    _Pragma("unroll") for (int rp_ = 0; rp_ <= ((REP_MASK >> 7) & 1); ++rp_) if (IN(7)) { if (rp_) xcd_barrier(bar); pg8::Gemm g{XB, (const bf16_t*)(ws + WS_WGU2), M, NGU, D, D}; pg8::StaticOrder So; So.init(M, NGU, F.G, cblk);
        pg8::EpiFfnUp E{H, nullptr, SS2}; pg8::gemm_phase(F.lds, g, So, E, F.wave); } SEAM(7);
    _Pragma("unroll") for (int rp_ = 0; rp_ <= ((REP_MASK >> 8) & 1); ++rp_) if (IN(8)) { if (rp_) xcd_barrier(bar); pg8::Gemm g{H, (const bf16_t*)(ws + WS_WD2), M, D, FF, FF}; pg8::StaticOrder So; So.init(M, D, F.G, cblk);
        pg8::EpiRes<true, true, false> E{nullptr, XB, P.out, nullptr, nullptr, 0.5f}; pg8::gemm_phase(F.lds, g, So, E, F.wave); }
#undef IN
#undef SEAM
}

extern "C" void kernel_launch(void* const* d_in, const int* in_sizes, int n_in, void* d_out, int out_size, void* d_ws, size_t ws_size, hipStream_t stream) {
    static int grid = 0;
    if (grid == 0) {
        if (n_in != 21 || out_size != M * D || ws_size < WS_END) { fprintf(stderr, "kernel_launch: unexpected shapes (n_in %d out %d ws %zu)\n", n_in, out_size, ws_size); grid = -1; return; }
        int dev = 0, cus = 0, per_cu = 0;
        if (hipGetDevice(&dev) != hipSuccess || hipDeviceGetAttribute(&cus, hipDeviceAttributeMultiprocessorCount, dev) != hipSuccess) { grid = -1; return; }
        if (hipFuncSetAttribute((const void*)mega_fwd, hipFuncAttributeMaxDynamicSharedMemorySize, LDS_BYTES) != hipSuccess) { fprintf(stderr, "kernel_launch: hipFuncSetAttribute failed\n"); grid = -1; return; }
        if (hipOccupancyMaxActiveBlocksPerMultiprocessor(&per_cu, (const void*)mega_fwd, 512, LDS_BYTES) != hipSuccess || per_cu < 1) { fprintf(stderr, "kernel_launch: occupancy query says %d blocks per CU\n", per_cu); grid = -1; (void)hipGetLastError(); return; }
        (void)hipGetLastError();
        grid = cus;
    }
    if (grid < 0) return;
    Args a{};
    { const float** pp = (const float**)&a.P; for (int i = 0; i < 21; ++i) pp[i] = (const float*)d_in[i]; }
    a.P.out = (float*)d_out; a.P.ws = (unsigned char*)d_ws;
    unsigned char* ws = a.P.ws;
    (void)hipMemsetAsync(ws + WS_CTL, 0, CTL_ZERO_BYTES, stream);
    a.ph_lo = 0; a.ph_hi = NPHASE; a.use_bar = 1;
    hipLaunchKernelGGL(mega_fwd, dim3(grid), dim3(512), LDS_BYTES, stream, a);
    return;
}
```

```cpp
#include <hip/hip_runtime.h>
#include <cstdint>
#include <cstdio>

constexpr int NB = 4, S = 8192, D = 1024, M = NB * S;
constexpr int FF = 2816, NGU = 2 * FF;
constexpr int HD = 64;
constexpr int NQKV = 2560, NGATE = 3072, INCOLS = NQKV + NGATE;
constexpr int QKVP = 2624;
constexpr int NMEM = 256, MROWS = NB * NMEM;
constexpr int NOC = 768;
constexpr float EPS = 1e-6f;
constexpr float LOG2E = 1.4426950408889634f;
constexpr float QSCALE = 0.125f * LOG2E;

typedef unsigned short bf16_t;
__device__ __forceinline__ float bf2f(bf16_t v) { return __uint_as_float(((unsigned)v) << 16); }
__device__ __forceinline__ bf16_t f2bf(float f) { unsigned u = __float_as_uint(f); return (bf16_t)((u + 0x7fffu + ((u >> 16) & 1u)) >> 16); }

constexpr size_t MiB = 1u << 20;
constexpr size_t WS_CTL = 0, CTL_ZERO_BYTES = 1 * MiB;
constexpr size_t WS_SS1 = 256 * 1024, WS_SS2 = 384 * 1024, WS_RSTD0 = 512 * 1024, WS_BIAS = 768 * 1024;
constexpr size_t WS_WGU1 = 2 * MiB, WS_WD1 = 13 * MiB, WS_WIN = 19 * MiB, WS_WGU2 = 30 * MiB, WS_WD2 = 41 * MiB, WS_WOUT = 47 * MiB, WS_WSB = 49 * MiB  , WS_WDIL = 51 * MiB, WS_WX = 52 * MiB, WS_WSB2 = 53 * MiB;
constexpr size_t WS_MK = 54 * MiB, WS_MVT = 55 * MiB;
constexpr size_t WS_XB = 64 * MiB;
constexpr size_t WS_BIG = 128 * MiB;
constexpr size_t WS_G = 296 * MiB;
constexpr size_t WS_END = 488 * MiB;
static_assert(WS_WGU1 + (size_t)NGU * D * 2 <= WS_WD1 && WS_WD1 + (size_t)D * FF * 2 <= WS_WIN && WS_WIN + (size_t)INCOLS * D * 2 <= WS_WGU2 && WS_WGU2 + (size_t)NGU * D * 2 <= WS_WD2 &&
              WS_WD2 + (size_t)D * FF * 2 <= WS_WOUT && WS_WOUT + (size_t)D * D * 2 <= WS_WSB && WS_XB + (size_t)M * D * 2 <= WS_BIG && WS_BIG + (size_t)M * QKVP * 2 <= WS_G && WS_G + (size_t)M * NGATE * 2 <= WS_END, "d_ws map");

__device__ const unsigned char T5B[3][129] = {
 {0,1,2,3,4,5,6,7,8,9,10,11,12,13,14,15,16,16,16,16,16,16,17,17,17,17,17,17,17,17,18,18,18,18,18,18,18,18,18,18,19,19,19,19,19,19,19,19,19,19,19,19,19,19,20,20,20,20,20,20,20,20,20,20,20,20,20,20,20,20,20,20,20,21,21,21,21,21,21,21,21,21,21,21,21,21,21,21,21,21,21,21,21,21,21,21,21,21,21,22,22,22,22,22,22,22,22,22,22,22,22,22,22,22,22,22,22,22,22,22,22,22,22,22,22,22,22,22,22},
 {0,4,8,12,16,16,17,17,18,18,19,19,19,19,20,20,20,20,20,21,21,21,21,21,21,22,22,22,22,22,22,22,22,22,23,23,23,23,23,23,23,23,23,23,23,23,24,24,24,24,24,24,24,24,24,24,24,24,24,24,24,24,25,25,25,25,25,25,25,25,25,25,25,25,25,25,25,25,25,25,25,25,25,26,26,26,26,26,26,26,26,26,26,26,26,26,26,26,26,26,26,26,26,26,26,26,26,26,26,26,26,26,26,27,27,27,27,27,27,27,27,27,27,27,27,27,27,27,27},
 {0,16,18,19,20,21,21,22,22,23,23,23,24,24,24,24,25,25,25,25,25,26,26,26,26,26,26,26,26,27,27,27,27,27,27,27,27,27,27,28,28,28,28,28,28,28,28,28,28,28,28,28,29,29,29,29,29,29,29,29,29,29,29,29,29,29,29,29,29,29,30,30,30,30,30,30,30,30,30,30,30,30,30,30,30,30,30,30,30,30,30,30,30,30,30,31,31,31,31,31,31,31,31,31,31,31,31,31,31,31,31,31,31,31,31,31,31,31,31,31,31,31,31,31,31,31,31,31,31}};

struct Ptrs {
    const float *x, *mem, *rel_bias, *ffn1_norm, *ffn1_w_gu, *ffn1_w_down, *mix_norm, *mem_norm, *w_in, *w_mem_kv,
                *dil_q_gain, *dil_k_gain, *x_q_gain, *x_k_gain, *w_br_sb, *w_br_dil, *w_br_x, *w_out, *ffn2_norm, *ffn2_w_gu, *ffn2_w_down;
    float* out; unsigned char* ws;
};

#ifndef PG8_USE_SP2
#define PG8_USE_SP2 1
#endif
namespace pg8 {
#define PG8_LAS __attribute__((address_space(3)))
typedef short bf16x8 __attribute__((ext_vector_type(8)));
typedef float f32x4 __attribute__((ext_vector_type(4)));
typedef float f32x2 __attribute__((ext_vector_type(2)));
typedef unsigned u32x4 __attribute__((ext_vector_type(4)));
typedef unsigned u32x2 __attribute__((ext_vector_type(2)));
constexpr int BM = 256, BK = 64, HALF = 128, HTB = HALF * BK * 2  , STAGE_BYTES = 8 * HTB, NXCD = 8, WGM = 8;

__host__ __device__ __forceinline__ int lds_byte(int r, int c) { const int st = (r >> 4) * 2 + (c >> 5), rr = r & 15, cc = c & 31, ob = rr * 64 + cc * 2; return st * 1024 + (ob ^ (((ob >> 9) & 1) << 5)); }
__host__ __device__ __forceinline__ void stage_rc(int b, int& R, int& C) { const int st = b / 1024, sb = b % 1024, swz = sb ^ (((sb >> 9) & 1) << 5); R = (st >> 1) * 16 + swz / 64; C = (st & 1) * 32 + (swz % 64) / 2; }
__host__ __device__ __forceinline__ int perm32(int rho) { const int n = rho >> 4, i = rho & 15; return 8 * (i >> 2) + 4 * n + (i & 3); }

struct Unit { int pm, pn, koff, ntu, step; };
struct Gemm { const bf16_t* A; const bf16_t* Bt; int M, N, K, lda, ldb; };

struct StaticOrder {
    int nM, nN, nwg, G, c;
    __host__ __device__ void init(int M_, int N_, int G_, int c_) { nM = M_ / BM; nN = N_ / BM; nwg = nM * nN; G = G_; c = c_; }
    __host__ __device__ bool next(int i, Unit& u) const {
        const long L = (long)i * G + c; if (L >= nwg) return false;
        int wgid = (int)L; { const int q = nwg / NXCD, r = nwg % NXCD, xcd = wgid % NXCD, off = wgid / NXCD; wgid = (xcd < r ? xcd * (q + 1) : r * (q + 1) + (xcd - r) * q) + off; }
        const int nig = WGM * nN, gid = wgid / nig, fm = gid * WGM, gsz = (nM - fm) < WGM ? (nM - fm) : WGM;
        u.pm = fm + ((wgid % nig) % gsz); u.pn = (wgid % nig) / gsz; u.koff = 0; u.ntu = 0; u.step = 0; return true;
    }
};

template <int K0, int N0, int K1, int N1, int K2, int N2> struct ChainOrder {
    StaticOrder S; int per;
    __host__ __device__ void init(int M_, int N_, int G_, int c_) { S.init(M_, N_, G_, c_); per = (S.nwg - c_ + G_ - 1) / G_; if (per < 0) per = 0; }
    __host__ __device__ bool next(int i, Unit& u) const { if (per == 0 || i >= 3 * per) return false; int s = 0, j = i; if (j >= per) { j -= per; s = 1; } if (j >= per) { j -= per; s = 2; }
        if (!S.next(j, u)) return false;
        int ko = K0, nu = N0; if (s == 1) { ko = K1; nu = N1; } if (s == 2) { ko = K2; nu = N2; }
        u.koff = ko; u.ntu = nu; u.step = s; return true; }
};

typedef float f32x2_t __attribute__((ext_vector_type(2))); typedef __bf16 bf16x2_t __attribute__((ext_vector_type(2)));
__device__ __forceinline__ unsigned cvt_pk_bf16(float lo, float hi) { const f32x2_t v = {lo, hi}; return __builtin_bit_cast(unsigned, __builtin_convertvector(v, bf16x2_t)); }
__device__ __forceinline__ float fast_sigmoid(float v) { return __builtin_amdgcn_rcpf(1.0f + __builtin_amdgcn_exp2f(-LOG2E * v)); }
__device__ __forceinline__ float sum_fq(float s) {
    const auto a = __builtin_amdgcn_permlane16_swap(__float_as_uint(s), __float_as_uint(s), false, false); s = __uint_as_float(a[0]) + __uint_as_float(a[1]);
    const auto b = __builtin_amdgcn_permlane32_swap(__float_as_uint(s), __float_as_uint(s), false, false); return __uint_as_float(b[0]) + __uint_as_float(b[1]); }
__device__ __forceinline__ void store16_wt(void* ptr, u32x4 v) { asm volatile("global_store_dwordx4 %0, %1, off sc1\n\ts_nop 1" :: "v"(ptr), "v"(v) : "memory"); }
__device__ __forceinline__ unsigned gate_q4(f32x4 v) { unsigned w = 0;
#pragma unroll
    for (int i = 0; i < 4; ++i) w = __builtin_amdgcn_cvt_pk_u8_f32(v[i] * 16.0f + 128.0f, i, w);
    return w; }
__device__ __forceinline__ f32x4 gate_dq4(unsigned w) { f32x4 g;
#pragma unroll
    for (int i = 0; i < 4; ++i) g[i] = ((float)((w >> (8 * i)) & 255u) - 128.0f) * 0.0625f;
    return g; }
__device__ __forceinline__ float row_rstd(const float* rstd, const float* ss, int row) { return rstd ? rstd[row] : __builtin_amdgcn_rsqf(ss[row] * (1.0f / D) + EPS); }

struct RowPre { float r[2][4]; };
struct EpiFfnUp {
    static constexpr bool PERM = true, FOLD = false, EPI_TWICE = false, EPI_DRY = false; static constexpr int TOUCH = 0;
    bf16_t* H; const float* rstd; const float* ss;
    static constexpr bool PRE = true;
    __device__ __forceinline__ RowPre pre(const Unit& u, int wr, int fr) const { RowPre q; const int row0 = u.pm * BM + wr * 64 + fr;
#pragma unroll
        for (int ai = 0; ai < 2; ++ai)
#pragma unroll
            for (int m = 0; m < 4; ++m) q.r[ai][m] = rstd ? rstd[row0 + ai * HALF + m * 16] : ss[row0 + ai * HALF + m * 16];
        return q; }
    __device__ __forceinline__ void operator()(const f32x4 (&acc)[2][2][4][2], const Unit& u, int wr, int wc, int fr, int fq, const RowPre& q) const {
        const int row0 = u.pm * BM + wr * 64 + fr, col0 = u.pn * 128 + wc * 32 + 8 * fq;
#pragma unroll
        for (int ai = 0; ai < 2; ++ai)
#pragma unroll
            for (int m = 0; m < 4; ++m) { const int row = row0 + ai * HALF + m * 16; const float r = rstd ? q.r[ai][m] : __builtin_amdgcn_rsqf(q.r[ai][m] * (1.0f / D) + EPS); float h[8];
#pragma unroll
                for (int n = 0; n < 2; ++n)
#pragma unroll
                    for (int i = 0; i < 4; ++i) { const float a = acc[ai][0][m][n][i] * r, b = acc[ai][1][m][n][i] * r; h[n * 4 + i] = a * fast_sigmoid(a) * b; }
                u32x4 w; w.x = cvt_pk_bf16(h[0], h[1]); w.y = cvt_pk_bf16(h[2], h[3]); w.z = cvt_pk_bf16(h[4], h[5]); w.w = cvt_pk_bf16(h[6], h[7]);
                store16_wt((void*)(H + (size_t)row * FF + col0), w); }
    }
};
struct EpiResOut {
    static constexpr bool PRE = false, PERM = true, FOLD = false, EPI_TWICE = false, EPI_DRY = false; static constexpr int TOUCH = 0;
    const bf16_t* xb; float* out; float alpha;
    __device__ __forceinline__ void operator()(const f32x4 (&acc)[2][2][4][2], const Unit& u, int wr, int wc, int fr, int fq) const {
        const int row0 = u.pm * BM + wr * 64 + fr, col0 = u.pn * BM + wc * 32 + 8 * fq;
        u32x4 rv[2][4][2];
#pragma unroll
        for (int ai = 0; ai < 2; ++ai)
#pragma unroll
            for (int m = 0; m < 4; ++m)
#pragma unroll
                for (int bj = 0; bj < 2; ++bj) rv[ai][m][bj] = *(const u32x4*)(xb + (size_t)(row0 + ai * HALF + m * 16) * D + col0 + bj * HALF);
        asm volatile("" ::: "memory");
#pragma unroll
        for (int ai = 0; ai < 2; ++ai)
#pragma unroll
            for (int m = 0; m < 4; ++m) { float* orow = out + (size_t)(row0 + ai * HALF + m * 16) * D + col0;
#pragma unroll
                for (int bj = 0; bj < 2; ++bj) { const u32x4 r = rv[ai][m][bj];
                    const f32x4 r0 = {__uint_as_float(r.x << 16), __uint_as_float(r.x & 0xffff0000u), __uint_as_float(r.y << 16), __uint_as_float(r.y & 0xffff0000u)};
                    const f32x4 r1 = {__uint_as_float(r.z << 16), __uint_as_float(r.z & 0xffff0000u), __uint_as_float(r.w << 16), __uint_as_float(r.w & 0xffff0000u)};
                    const f32x4 o0 = r0 + acc[ai][bj][m][0] * alpha, o1 = r1 + acc[ai][bj][m][1] * alpha;
                    store16_wt((void*)(orow + bj * HALF), __builtin_bit_cast(u32x4, o0)); store16_wt((void*)(orow + bj * HALF + 4), __builtin_bit_cast(u32x4, o1)); } }
        asm volatile("" ::: "memory");
    }
};
struct EpiResB {
    static constexpr bool PRE = false, PERM = true, FOLD = false, EPI_TWICE = false, EPI_DRY = false; static constexpr int TOUCH = 0;
    bf16_t* xb; float* ss; float alpha;
    __device__ __forceinline__ void operator()(const f32x4 (&acc)[2][2][4][2], const Unit& u, int wr, int wc, int fr, int fq) const {
        const int row0 = u.pm * BM + wr * 64 + fr, col0 = u.pn * BM + wc * 32 + 8 * fq;
        u32x4 rv[2][4][2];
#pragma unroll
        for (int ai = 0; ai < 2; ++ai)
#pragma unroll
            for (int m = 0; m < 4; ++m)
#pragma unroll
                for (int bj = 0; bj < 2; ++bj) rv[ai][m][bj] = *(const u32x4*)(xb + (size_t)(row0 + ai * HALF + m * 16) * D + col0 + bj * HALF);
        asm volatile("" ::: "memory");
#pragma unroll
        for (int ai = 0; ai < 2; ++ai)
#pragma unroll
            for (int m = 0; m < 4; ++m) { const int row = row0 + ai * HALF + m * 16; float s = 0.f;
#pragma unroll
                for (int bj = 0; bj < 2; ++bj) { const u32x4 r = rv[ai][m][bj];
                    const f32x4 r0 = {__uint_as_float(r.x << 16), __uint_as_float(r.x & 0xffff0000u), __uint_as_float(r.y << 16), __uint_as_float(r.y & 0xffff0000u)};
                    const f32x4 r1 = {__uint_as_float(r.z << 16), __uint_as_float(r.z & 0xffff0000u), __uint_as_float(r.w << 16), __uint_as_float(r.w & 0xffff0000u)};
                    const f32x4 o0 = r0 + acc[ai][bj][m][0] * alpha, o1 = r1 + acc[ai][bj][m][1] * alpha;
                    s += (o0[0] * o0[0] + o0[1] * o0[1]) + (o0[2] * o0[2] + o0[3] * o0[3]) + (o1[0] * o1[0] + o1[1] * o1[1]) + (o1[2] * o1[2] + o1[3] * o1[3]);
                    u32x4 w; w.x = cvt_pk_bf16(o0[0], o0[1]); w.y = cvt_pk_bf16(o0[2], o0[3]); w.z = cvt_pk_bf16(o1[0], o1[1]); w.w = cvt_pk_bf16(o1[2], o1[3]);
                    store16_wt((void*)(xb + (size_t)row * D + col0 + bj * HALF), w); }
                if (ss) { s = sum_fq(s); if (fq == 0) atomicAdd(ss + row, s); } }
        asm volatile("" ::: "memory");
    }
};
template <bool RES_BF16, bool OUT_F32, bool OUT_BF16> struct EpiRes {
    static constexpr bool PRE = false, PERM = false, FOLD = false, EPI_TWICE = false, EPI_DRY = false;
    static constexpr int TOUCH = 0;
    static constexpr int NB = RES_BF16 ? 1 : 2;
    const float* resf; const bf16_t* resb; float* out; bf16_t* xb; float* ss; float alpha;
    __device__ __forceinline__ void operator()(const f32x4 (&acc)[2][2][4][2], const Unit& u, int wr, int wc, int fr, int fq) const {
        const int row0 = u.pm * BM + wr * 64 + fr, col0 = u.pn * BM + wc * 32 + 4 * fq;
#pragma unroll
        for (int bt = 0; bt < NB; ++bt) {
            f32x4 rvf[RES_BF16 ? 1 : 1][RES_BF16 ? 1 : 4][2][2]; u32x2 rvb[RES_BF16 ? 2 : 1][RES_BF16 ? 4 : 1][2][2];
#pragma unroll
            for (int a2 = 0; a2 < 2 / NB; ++a2)
#pragma unroll
                for (int m = 0; m < 4; ++m) { const int ai = bt * (2 / NB) + a2; const size_t off = (size_t)(row0 + ai * HALF + m * 16) * D + col0;
#pragma unroll
                    for (int bj = 0; bj < 2; ++bj)
#pragma unroll
                        for (int n = 0; n < 2; ++n) { if (RES_BF16) rvb[a2][m][bj][n] = *(const u32x2*)(resb + off + bj * HALF + n * 16); else rvf[0][m][bj][n] = *(const f32x4*)(resf + off + bj * HALF + n * 16); } }
            asm volatile("" ::: "memory");
#pragma unroll
            for (int a2 = 0; a2 < 2 / NB; ++a2)
#pragma unroll
                for (int m = 0; m < 4; ++m) { const int ai = bt * (2 / NB) + a2, row = row0 + ai * HALF + m * 16; const size_t off = (size_t)row * D + col0; float s = 0.f;
#pragma unroll
                    for (int bj = 0; bj < 2; ++bj)
#pragma unroll
                        for (int n = 0; n < 2; ++n) {
                            f32x4 rv;
                            if (RES_BF16) { const u32x2 w = rvb[a2][m][bj][n]; rv = (f32x4){__uint_as_float(w.x << 16), __uint_as_float(w.x & 0xffff0000u), __uint_as_float(w.y << 16), __uint_as_float(w.y & 0xffff0000u)}; }
                            else rv = rvf[0][m][bj][n];
                            const f32x4 o = rv + acc[ai][bj][m][n] * alpha;
                            if (OUT_F32) *(f32x4*)(out + off + bj * HALF + n * 16) = o;
                            s += (o[0] * o[0] + o[1] * o[1]) + (o[2] * o[2] + o[3] * o[3]);
                            if (OUT_BF16) { u32x2 w; w.x = cvt_pk_bf16(o[0], o[1]); w.y = cvt_pk_bf16(o[2], o[3]); *(u32x2*)(xb + off + bj * HALF + n * 16) = w; } }
                    if (ss) { s = sum_fq(s); if (fq == 0) atomicAdd(ss + row, s); } }
            asm volatile("" ::: "memory"); }
    }
};
struct EpiWin {
    static constexpr bool PERM = true, FOLD = false, EPI_TWICE = false, EPI_DRY = false; static constexpr int TOUCH = 0;
    bf16_t* QKV; unsigned char* G; const float* ss1; const float *gq, *gk, *gxq; bf16_t* dry; bf16_t* drybase;
    static constexpr bool PRE = true;
    __device__ __forceinline__ RowPre pre(const Unit& u, int wr, int fr) const { RowPre q; const int row0 = u.pm * BM + wr * 64 + fr;
#pragma unroll
        for (int ai = 0; ai < 2; ++ai)
#pragma unroll
            for (int m = 0; m < 4; ++m) q.r[ai][m] = ss1[row0 + ai * HALF + m * 16];
        return q; }
    __device__ __forceinline__ void operator()(const f32x4 (&acc)[2][2][4][2], const Unit& u, int wr, int wc, int fr, int fq, const RowPre& q) const {
        const int row0 = u.pm * BM + wr * 64 + fr;
        if (u.pn >= 10) {
            const int col0 = (u.pn - 10) * BM + wc * 64 + 16 * fq;
#pragma unroll
            for (int ai = 0; ai < 2; ++ai)
#pragma unroll
                for (int m = 0; m < 4; ++m) { const int row = row0 + ai * HALF + m * 16; const float r = __builtin_amdgcn_rsqf(q.r[ai][m] * (1.0f / D) + EPS); u32x4 w;
                    w.x = gate_q4(acc[ai][0][m][0] * r); w.y = gate_q4(acc[ai][0][m][1] * r); w.z = gate_q4(acc[ai][1][m][0] * r); w.w = gate_q4(acc[ai][1][m][1] * r);
                    store16_wt((void*)(G + (size_t)row * NGATE + col0), w); }
            return;
        }
        const int head = 4 * u.pn + wc;
        const bool norm = (head >= 18 && head < 30) || head >= 36;
        const float* gain = (head >= 18 && head < 24) ? gq : (head >= 24 && head < 30) ? gk : (head >= 36) ? gxq : nullptr;
        const float cs = (head < 6 || (head >= 18 && head < 24) || head >= 36) ? QSCALE : 1.0f;
        f32x4 mul[2][2];
#pragma unroll
        for (int bj = 0; bj < 2; ++bj)
#pragma unroll
            for (int n = 0; n < 2; ++n) { f32x4 g = {1.f, 1.f, 1.f, 1.f}; if (gain) g = *(const f32x4*)(gain + 32 * bj + 8 * fq + 4 * n); mul[bj][n] = g * cs; }
#pragma unroll
        for (int ai = 0; ai < 2; ++ai)
#pragma unroll
            for (int m = 0; m < 4; ++m) { const int row = row0 + ai * HALF + m * 16; const float r = __builtin_amdgcn_rsqf(q.r[ai][m] * (1.0f / D) + EPS); f32x4 v[2][2]; float s = 0.f;
#pragma unroll
                for (int bj = 0; bj < 2; ++bj)
#pragma unroll
                    for (int n = 0; n < 2; ++n) { v[bj][n] = acc[ai][bj][m][n] * r; const f32x4 t = v[bj][n]; s += (t[0] * t[0] + t[1] * t[1]) + (t[2] * t[2] + t[3] * t[3]); }
                float hr = 1.0f;
                if (norm) { s = sum_fq(s); hr = __builtin_amdgcn_rsqf(s * (1.0f / HD) + EPS); }
#pragma unroll
                for (int bj = 0; bj < 2; ++bj) { const f32x4 v0 = v[bj][0] * mul[bj][0] * hr, v1 = v[bj][1] * mul[bj][1] * hr; u32x4 w;
                    w.x = cvt_pk_bf16(v0[0], v0[1]); w.y = cvt_pk_bf16(v0[2], v0[3]); w.z = cvt_pk_bf16(v1[0], v1[1]); w.w = cvt_pk_bf16(v1[2], v1[3]);
                    store16_wt((void*)(QKV + ((size_t)head * M + row) * 64 + bj * 32 + 8 * fq), w); } }
    }
};
template <int STEP> struct EpiBranch {
    static constexpr bool PRE = false, PERM = true, FOLD = false, EPI_TWICE = false, EPI_DRY = false; static constexpr int TOUCH = 0;
    static constexpr int NB = STEP > 0 ? 2 : 1;
    const unsigned char* G; bf16_t* macc; bf16_t* merged;
    static __device__ __forceinline__ void up8(f32x4& lo, f32x4& hi, u32x4 w) {
        lo = (f32x4){__uint_as_float(w.x << 16), __uint_as_float(w.x & 0xffff0000u), __uint_as_float(w.y << 16), __uint_as_float(w.y & 0xffff0000u)};
        hi = (f32x4){__uint_as_float(w.z << 16), __uint_as_float(w.z & 0xffff0000u), __uint_as_float(w.w << 16), __uint_as_float(w.w & 0xffff0000u)}; }
    __device__ __forceinline__ void operator()(const f32x4 (&acc)[2][2][4][2], const Unit& u, int wr, int wc, int fr, int fq) const {
        const int row0 = u.pm * BM + wr * 64 + fr, col0 = u.pn * BM + wc * 32 + 8 * fq;
#pragma unroll
        for (int bt = 0; bt < NB; ++bt) {
            u32x2 gw[2 / NB][4][2]; u32x4 mw[1][STEP > 0 ? 4 : 1][2];
#pragma unroll
            for (int a2 = 0; a2 < 2 / NB; ++a2)
#pragma unroll
                for (int m = 0; m < 4; ++m) { const int ai = bt * (2 / NB) + a2, row = row0 + ai * HALF + m * 16;
#pragma unroll
                    for (int bj = 0; bj < 2; ++bj) { const int col = col0 + bj * HALF; gw[a2][m][bj] = *(const u32x2*)(G + (size_t)row * NGATE + col + STEP * D);
                        if (STEP > 0) mw[0][m][bj] = *(const u32x4*)(macc + (size_t)row * D + col); } }
            asm volatile("" ::: "memory");
#pragma unroll
            for (int a2 = 0; a2 < 2 / NB; ++a2)
#pragma unroll
                for (int m = 0; m < 4; ++m) { const int ai = bt * (2 / NB) + a2, row = row0 + ai * HALF + m * 16;
#pragma unroll
                    for (int bj = 0; bj < 2; ++bj) { const int col = col0 + bj * HALF;
                        f32x4 g0 = gate_dq4(gw[a2][m][bj].x), g1 = gate_dq4(gw[a2][m][bj].y);
#pragma unroll
                        for (int i = 0; i < 4; ++i) { g0[i] = fast_sigmoid(g0[i]); g1[i] = fast_sigmoid(g1[i]); }
                        f32x4 v0 = g0 * acc[ai][bj][m][0], v1 = g1 * acc[ai][bj][m][1];
                        if (STEP > 0) { f32x4 m0, m1; up8(m0, m1, mw[0][m][bj]); v0 += m0; v1 += m1; }
                        u32x4 w; w.x = cvt_pk_bf16(v0[0], v0[1]); w.y = cvt_pk_bf16(v0[2], v0[3]); w.z = cvt_pk_bf16(v1[0], v1[1]); w.w = cvt_pk_bf16(v1[2], v1[3]);
                        *(u32x4*)((STEP < 2 ? macc : merged) + (size_t)row * D + col) = w; } }
            asm volatile("" ::: "memory"); }
    }
};

struct EpiBranchChain {
    static constexpr bool PRE = false, PERM = true, FOLD = false, EPI_TWICE = false, EPI_DRY = false; static constexpr int TOUCH = 0;
    const unsigned char* G; bf16_t* macc; bf16_t* merged;
    struct Q { u32x2 g[2][2]; u32x4 m[2][2]; };
    __device__ __forceinline__ void operator()(const f32x4 (&acc)[2][2][4][2], const Unit& u, int wr, int wc, int fr, int fq) const {
        const int row0 = u.pm * BM + wr * 64 + fr, col0 = u.pn * BM + wc * 32 + 8 * fq, step = u.step;
        const unsigned char* gb = G + step * D; bf16_t* dst = step < 2 ? macc : merged;
        auto load = [&](Q& s, const int q) __attribute__((always_inline)) {
#pragma unroll
            for (int mm = 0; mm < 2; ++mm) { const int row = row0 + (q >> 1) * HALF + (2 * (q & 1) + mm) * 16;
#pragma unroll
                for (int bj = 0; bj < 2; ++bj) { s.g[mm][bj] = *(const u32x2*)(gb + (size_t)row * NGATE + col0 + bj * HALF); s.m[mm][bj] = (u32x4){0u, 0u, 0u, 0u}; } }
            if (step > 0) {
#pragma unroll
                for (int mm = 0; mm < 2; ++mm)
#pragma unroll
                    for (int bj = 0; bj < 2; ++bj) s.m[mm][bj] = *(const u32x4*)(macc + (size_t)(row0 + (q >> 1) * HALF + (2 * (q & 1) + mm) * 16) * D + col0 + bj * HALF); }
        };
        auto work = [&](const Q& s, const int q) __attribute__((always_inline)) {
#pragma unroll
            for (int mm = 0; mm < 2; ++mm) { const int ai = q >> 1, m = 2 * (q & 1) + mm, row = row0 + ai * HALF + m * 16;
#pragma unroll
                for (int bj = 0; bj < 2; ++bj) { const int col = col0 + bj * HALF;
                    f32x4 g0 = gate_dq4(s.g[mm][bj].x), g1 = gate_dq4(s.g[mm][bj].y), m0, m1;
#pragma unroll
                    for (int i = 0; i < 4; ++i) { g0[i] = fast_sigmoid(g0[i]); g1[i] = fast_sigmoid(g1[i]); }
                    EpiBranch<1>::up8(m0, m1, s.m[mm][bj]);
                    const f32x4 v0 = g0 * acc[ai][bj][m][0] + m0, v1 = g1 * acc[ai][bj][m][1] + m1;
                    u32x4 w; w.x = cvt_pk_bf16(v0[0], v0[1]); w.y = cvt_pk_bf16(v0[2], v0[3]); w.z = cvt_pk_bf16(v1[0], v1[1]); w.w = cvt_pk_bf16(v1[2], v1[3]);
                    store16_wt((void*)(dst + (size_t)row * D + col), w); } }
        };
        Q sa, sb;
        load(sa, 0); load(sb, 1); asm volatile("" ::: "memory");
        work(sa, 0); asm volatile("" ::: "memory"); load(sa, 2); asm volatile("" ::: "memory");
        work(sb, 1); asm volatile("" ::: "memory"); load(sb, 3); asm volatile("" ::: "memory");
        work(sa, 2); asm volatile("" ::: "memory");
        work(sb, 3); asm volatile("" ::: "memory");
    }
};

template <class Epi, class Sched>
__device__ __forceinline__ void gemm_phase(PG8_LAS unsigned char* lds, const Gemm g, const Sched& S, const Epi& E, const int wid  ) {
    int lane; asm volatile("v_mbcnt_lo_u32_b32 %0, -1, 0\n\tv_mbcnt_hi_u32_b32 %0, -1, %0" : "=v"(lane));
    const int tid = wid * 64 + lane, wr = wid >> 2, wc = wid & 3, fr = lane & 15, fq = lane >> 4;
    const int ldb = g.ldb, lda = g.lda; int nt = g.K / BK;
    unsigned voffA[2], voffB[2];
#pragma unroll
    for (int i = 0; i < 2; ++i) { int R, C; stage_rc(tid * 16 + i * 8192, R, C); const int Rb = Epi::PERM ? ((R & ~31) + perm32(R & 31)) : R;
        voffA[i] = (unsigned)(R * lda + C) * 2u; voffB[i] = (unsigned)(Rb * ldb + C) * 2u; }
    const size_t kstep = (size_t)(BK * 2);
    const size_t hsA = (size_t)HALF * lda * 2, hsB = (size_t)HALF * ldb * 2;
    const size_t tsA = 2 * hsA, tsB = 2 * hsB;
    const unsigned ldsw = (unsigned)wid * 1024u;
    const int aoff = lds_byte(wr * 64 + fr, fq * 8), boff = lds_byte(wc * 32 + fr, fq * 8);
#define PG8_SA(b, h) (((b) * 2 + (h)) * HTB)
#define PG8_SB(b, h) ((4 + (b) * 2 + (h)) * HTB)
#define PG8_STAGE(bufoff, gbase, voff) do { _Pragma("unroll") for (int _i = 0; _i < 2; ++_i) \
        __builtin_amdgcn_global_load_lds((const unsigned*)((const char*)(gbase) + (voff)[_i]), (PG8_LAS unsigned*)(lds + (bufoff) + ldsw + _i * 8192), 16, 0, 0); } while (0)
    PG8_LAS const unsigned char* ldsA = lds + aoff; PG8_LAS const unsigned char* ldsB = lds + 4 * HTB + boff;
    asm volatile("" : "+v"(ldsA), "+v"(ldsB));
#define PG8_LDA(dst, b, h) do { _Pragma("unroll") for (int m = 0; m < 4; ++m) _Pragma("unroll") for (int k = 0; k < 2; ++k) dst[m][k] = *(const PG8_LAS bf16x8*)(ldsA + ((b) * 2 + (h)) * HTB + m * 2048 + k * 1024); } while (0)
#define PG8_LDB(dst, b, h) do { _Pragma("unroll") for (int n = 0; n < 2; ++n) _Pragma("unroll") for (int k = 0; k < 2; ++k) dst[n][k] = *(const PG8_LAS bf16x8*)(ldsB + ((b) * 2 + (h)) * HTB + n * 2048 + k * 1024); } while (0)
#define PG8_MMA(ai, bj, At, Bt) do { __builtin_amdgcn_s_setprio(1); _Pragma("unroll") for (int m = 0; m < 4; ++m) _Pragma("unroll") for (int n = 0; n < 2; ++n) _Pragma("unroll") for (int k = 0; k < 2; ++k) \
        acc[ai][bj][m][n] = __builtin_amdgcn_mfma_f32_16x16x32_bf16(Bt[n][k], At[m][k], acc[ai][bj][m][n], 0, 0, 0); __builtin_amdgcn_s_setprio(0); } while (0)
#define PG8_WAIT_V(n) asm volatile("s_waitcnt vmcnt(" #n ")" ::: "memory")
#define PG8_WAIT_L(n) asm volatile("s_waitcnt lgkmcnt(" #n ")" ::: "memory")
#define PG8_BAR __builtin_amdgcn_s_barrier()
#define PG8_SCHED __builtin_amdgcn_sched_barrier(0)
#if !PG8_USE_SP2
#define PG8_KTILE2(t) do { \
            const bool last = (t == nt - 2); \
            const char* a1 = cA + (size_t)(t + 1) * kstep; \
            const char* a2 = last ? nA : cA + (size_t)(t + 2) * kstep; const char* b2 = last ? nB : cB + (size_t)(t + 2) * kstep; \
            const char* a3 = a2 + kstep; const char* b3 = b2 + kstep; \
            PG8_LDB(B0, 0, 0); PG8_SCHED; PG8_LDA(At, 0, 0); PG8_STAGE(PG8_SA(1, 1), a1 + hsA, voffA); \
            PG8_WAIT_L(8); PG8_BAR; PG8_WAIT_L(0); PG8_MMA(0, 0, At, B0); PG8_BAR; PG8_SCHED; \
            PG8_LDB(B1, 0, 1); PG8_STAGE(PG8_SB(0, 0), b2, voffB); \
            PG8_BAR; PG8_WAIT_L(0); PG8_MMA(0, 1, At, B1); PG8_BAR; \
            PG8_LDA(At, 0, 1); PG8_STAGE(PG8_SA(0, 0), a2, voffA); \
            PG8_BAR; PG8_WAIT_L(0); PG8_MMA(1, 0, At, B0); PG8_BAR; PG8_SCHED; \
            PG8_STAGE(PG8_SB(0, 1), b2 + hsB, voffB); \
            PG8_WAIT_V(6); PG8_BAR; PG8_MMA(1, 1, At, B1); PG8_BAR; \
            PG8_LDB(B0, 1, 0); PG8_SCHED; PG8_LDA(At, 1, 0); PG8_STAGE(PG8_SA(0, 1), a2 + hsA, voffA); \
            PG8_WAIT_L(8); PG8_BAR; PG8_WAIT_L(0); PG8_MMA(0, 0, At, B0); PG8_BAR; PG8_SCHED; \
            PG8_LDB(B1, 1, 1); PG8_STAGE(PG8_SB(1, 0), b3, voffB); \
            PG8_BAR; PG8_WAIT_L(0); PG8_MMA(0, 1, At, B1); PG8_BAR; \
            PG8_LDA(At, 1, 1); PG8_STAGE(PG8_SA(1, 0), a3, voffA); \
            PG8_BAR; PG8_WAIT_L(0); PG8_MMA(1, 0, At, B0); PG8_BAR; PG8_SCHED; \
            PG8_STAGE(PG8_SB(1, 1), b3 + hsB, voffB); \
            PG8_WAIT_V(6); PG8_BAR; PG8_MMA(1, 1, At, B1); PG8_BAR; \
        } while (0)
#else
#define PG8_KTILE2(t) do { \
            const bool last = (t == nt - 2); \
            const char* a1 = cA + (size_t)(t + 1) * kstep; \
            const char* a2 = last ? nA : cA + (size_t)(t + 2) * kstep; const char* b2 = last ? nB : cB + (size_t)(t + 2) * kstep; \
            const char* a3 = a2 + kstep; const char* b3 = b2 + kstep; \
            PG8_LDB(B0, 0, 0); PG8_LDB(B1, 0, 1); PG8_SCHED; PG8_LDA(At, 0, 0); PG8_STAGE(PG8_SA(1, 1), a1 + hsA, voffA); \
            PG8_WAIT_V(8); PG8_WAIT_L(0); PG8_BAR; PG8_MMA(0, 0, At, B0); PG8_MMA(0, 1, At, B1); PG8_BAR; PG8_SCHED; \
            PG8_LDA(At, 0, 1); PG8_STAGE(PG8_SB(0, 0), b2, voffB); PG8_STAGE(PG8_SB(0, 1), b2 + hsB, voffB); PG8_STAGE(PG8_SA(0, 0), a2, voffA); \
            PG8_WAIT_V(8); PG8_WAIT_L(0); PG8_BAR; PG8_MMA(1, 0, At, B0); PG8_MMA(1, 1, At, B1); PG8_BAR; PG8_SCHED; \
            PG8_LDB(B0, 1, 0); PG8_LDB(B1, 1, 1); PG8_SCHED; PG8_LDA(At, 1, 0); PG8_STAGE(PG8_SA(0, 1), a2 + hsA, voffA); \
            PG8_WAIT_V(8); PG8_WAIT_L(0); PG8_BAR; PG8_MMA(0, 0, At, B0); PG8_MMA(0, 1, At, B1); PG8_BAR; PG8_SCHED; \
            PG8_LDA(At, 1, 1); PG8_STAGE(PG8_SB(1, 0), b3, voffB); PG8_STAGE(PG8_SB(1, 1), b3 + hsB, voffB); PG8_STAGE(PG8_SA(1, 0), a3, voffA); \
            PG8_WAIT_V(8); PG8_WAIT_L(0); PG8_BAR; PG8_MMA(1, 0, At, B0); PG8_MMA(1, 1, At, B1); PG8_BAR; PG8_SCHED; \
        } while (0)
#endif
    Unit cur, nxt; int ui = 0;
    if (!S.next(0, cur)) return;
    f32x4 acc[2][2][4][2];
#pragma unroll
    for (int a = 0; a < 2; ++a)
#pragma unroll
        for (int b = 0; b < 2; ++b)
#pragma unroll
            for (int m = 0; m < 4; ++m)
#pragma unroll
                for (int n = 0; n < 2; ++n) acc[a][b][m][n] = (f32x4){0.f, 0.f, 0.f, 0.f};
    bf16x8 At[4][2], B0[2][2], B1[2][2];
    const char* cA = (const char*)g.A + (size_t)cur.pm * tsA + (size_t)cur.koff * 2; const char* cB = (const char*)g.Bt + (size_t)cur.pn * tsB + (size_t)cur.koff * 2;
    if (cur.ntu) nt = cur.ntu;
#if PG8_USE_SP2
    PG8_STAGE(PG8_SB(0, 0), cB, voffB); PG8_STAGE(PG8_SB(0, 1), cB + hsB, voffB); PG8_STAGE(PG8_SA(0, 0), cA, voffA); PG8_STAGE(PG8_SA(0, 1), cA + hsA, voffA);
    if (wr == 1) PG8_BAR;
    PG8_WAIT_V(2); PG8_BAR;
#else
    PG8_STAGE(PG8_SB(0, 0), cB, voffB); PG8_STAGE(PG8_SA(0, 0), cA, voffA); PG8_STAGE(PG8_SB(0, 1), cB + hsB, voffB); PG8_STAGE(PG8_SA(0, 1), cA + hsA, voffA);
    if (wr == 1) PG8_BAR;
    PG8_WAIT_V(4); PG8_BAR;
#endif
    PG8_STAGE(PG8_SB(1, 0), cB + kstep, voffB); PG8_STAGE(PG8_SA(1, 0), cA + kstep, voffA); PG8_STAGE(PG8_SB(1, 1), cB + hsB + kstep, voffB);
    PG8_WAIT_V(6); PG8_BAR;
    for (;;) {
        RowPre rowpre; if constexpr (Epi::PRE) rowpre = E.pre(cur, wr, fr);
        const bool has_next = S.next(ui + 1, nxt);
        const char* nA = has_next ? (const char*)g.A + (size_t)nxt.pm * tsA + (size_t)nxt.koff * 2 : cA; const char* nB = has_next ? (const char*)g.Bt + (size_t)nxt.pn * tsB + (size_t)nxt.koff * 2 : cB;
        if constexpr (Epi::FOLD) {
            static_assert(Epi::NT == 12 && Epi::F1 == 6 && Epi::F2 == 8, "the fold walk below is written out for K = 384 | 128 | 256");
            PG8_KTILE2(0); PG8_KTILE2(2); PG8_KTILE2(4);
            PG8_SCHED; E.fold(acc, cur, 0, wr, wc, fr, fq); PG8_SCHED;
            PG8_KTILE2(6);
            PG8_SCHED; E.fold(acc, cur, 1, wr, wc, fr, fq); PG8_SCHED;
            PG8_KTILE2(8); PG8_KTILE2(10);
        } else {
            for (int t = 0; t < nt; t += 2) { if constexpr (Epi::TOUCH > 0) { if (t < 2 * Epi::TOUCH) E.touch(cur, t >> 1, wid, lane, lds); } PG8_KTILE2(t); }
        }
        if (wr == 0) PG8_BAR;
        if constexpr (Epi::PRE) E(acc, cur, wr, wc, fr, fq, rowpre); else E(acc, cur, wr, wc, fr, fq);
        if (!has_next) break;
#pragma unroll
        for (int a = 0; a < 2; ++a)
#pragma unroll
            for (int b = 0; b < 2; ++b)
#pragma unroll
                for (int m = 0; m < 4; ++m)
#pragma unroll
                    for (int n = 0; n < 2; ++n) acc[a][b][m][n] = (f32x4){0.f, 0.f, 0.f, 0.f};
        cur = nxt; cA = nA; cB = nB; ++ui; if (cur.ntu) nt = cur.ntu;
        if (wr == 1) PG8_BAR;
    }
    PG8_WAIT_V(0);
    PG8_BAR;
#undef PG8_SA
#undef PG8_SB
#undef PG8_STAGE
#undef PG8_LDA
#undef PG8_LDB
#undef PG8_MMA
#undef PG8_WAIT_V
#undef PG8_WAIT_L
#undef PG8_BAR
#undef PG8_SCHED
#undef PG8_KTILE2
}
}

namespace att {
#define ATT_LAS __attribute__((address_space(3)))
typedef short bf16x8 __attribute__((ext_vector_type(8)));
typedef short s16x4 __attribute__((ext_vector_type(4)));
typedef float f32x16 __attribute__((ext_vector_type(16)));
typedef unsigned u32x2 __attribute__((ext_vector_type(2)));
typedef unsigned u32x4 __attribute__((ext_vector_type(4)));
constexpr int KSTRIDE = 144, KSTAGE = 32 * KSTRIDE;
constexpr int VSTRIDE = 192, VSTAGE = 32 * VSTRIDE;
constexpr int WSTAGE = KSTAGE + VSTAGE;
constexpr int TBLN = 132;
constexpr int LDS_TBL = 0, LDS_VST = 4096, LDS_BYTES = LDS_VST + 8 * WSTAGE;
constexpr float NEG = -1e30f;
__device__ __forceinline__ int crow(int r, int hi) { return (r & 3) + 8 * (r >> 2) + 4 * hi; }
typedef float f32x2_t __attribute__((ext_vector_type(2))); typedef __bf16 bf16x2_t __attribute__((ext_vector_type(2)));
__device__ __forceinline__ unsigned cvtpk(float lo, float hi) { const f32x2_t v = {lo, hi}; return __builtin_bit_cast(unsigned, __builtin_convertvector(v, bf16x2_t)); }

__device__ __forceinline__ void load_frag4(bf16x8 (&f)[4], const bf16_t* rowp, int hi) {
#pragma unroll
    for (int d0 = 0; d0 < 4; ++d0) f[d0] = *(const bf16x8*)(rowp + d0 * 16 + hi * 8);
}
__device__ __forceinline__ f32x16 qk_tile(const bf16x8 (&kf)[4], const bf16x8 (&qf)[4]) {
    f32x16 s = {0.f, 0.f, 0.f, 0.f, 0.f, 0.f, 0.f, 0.f, 0.f, 0.f, 0.f, 0.f, 0.f, 0.f, 0.f, 0.f};
#pragma unroll
    for (int d0 = 0; d0 < 4; ++d0) s = __builtin_amdgcn_mfma_f32_32x32x16_bf16(kf[d0], qf[d0], s, 0, 0, 0);
    return s;
}
struct TileRegs { u32x4 k[4], v[4]; };
template <class KRow, class VRow> __device__ __forceinline__ void load_tile(TileRegs& t, KRow krow, VRow vrow, int lane) {
#pragma unroll
    for (int j = 0; j < 4; ++j) { const int r = 8 * j + (lane >> 3); t.k[j] = *(const u32x4*)(krow(r) + (lane & 7) * 8); t.v[j] = *(const u32x4*)(vrow(r) + (lane & 7) * 8); }
}
__device__ __forceinline__ void stage_tile(ATT_LAS unsigned char* st, const TileRegs& t, int lane) {
#pragma unroll
    for (int j = 0; j < 4; ++j) { const int r = 8 * j + (lane >> 3);
        *(ATT_LAS u32x4*)(st + r * KSTRIDE + (lane & 7) * 16) = t.k[j]; *(ATT_LAS u32x4*)(st + KSTAGE + r * VSTRIDE + (lane & 7) * 16) = t.v[j]; }
}
__device__ __forceinline__ void read_kfrag(bf16x8 (&kf)[4], ATT_LAS const unsigned char* st, int lane) {
    ATT_LAS const unsigned char* p = st + (lane & 31) * KSTRIDE + (lane >> 5) * 16;
#pragma unroll
    for (int d0 = 0; d0 < 4; ++d0) kf[d0] = *(ATT_LAS const bf16x8*)(p + d0 * 32);
}
typedef short v4i16_t __attribute__((ext_vector_type(4)));
__device__ __forceinline__ s16x4 vtr(ATT_LAS const unsigned char* p) { return __builtin_bit_cast(s16x4, __builtin_amdgcn_ds_read_tr16_b64_v4i16((ATT_LAS v4i16_t*)p)); }
__device__ __forceinline__ void read_vfrag(bf16x8 (&vf)[2][2], ATT_LAS const unsigned char* vb) {
#pragma unroll
    for (int s = 0; s < 2; ++s)
#pragma unroll
        for (int d0 = 0; d0 < 2; ++d0) { const s16x4 lo = vtr(vb + (16 * s) * VSTRIDE + 64 * d0), hi = vtr(vb + (16 * s + 8) * VSTRIDE + 64 * d0);
            vf[s][d0] = (bf16x8){lo[0], lo[1], lo[2], lo[3], hi[0], hi[1], hi[2], hi[3]}; }
}
__device__ __forceinline__ void pv_mma(f32x16 (&o)[2], const bf16x8 (&vf)[2][2], const bf16x8 (&pw)[2]) {
#pragma unroll
    for (int s = 0; s < 2; ++s)
#pragma unroll
        for (int d0 = 0; d0 < 2; ++d0) o[d0] = __builtin_amdgcn_mfma_f32_32x32x16_bf16(vf[s][d0], pw[s], o[d0], 0, 0, 0);
}
__device__ __forceinline__ float swap32(float x) { const auto rr = __builtin_amdgcn_permlane32_swap(__float_as_uint(x), __float_as_uint(x), false, false); return __uint_as_float((__builtin_amdgcn_mbcnt_hi(~0u, __builtin_amdgcn_mbcnt_lo(~0u, 0u)) < 32u) ? rr[1] : rr[0]); }
__device__ __forceinline__ void pack_p(bf16x8 (&pw)[2], const f32x16& p) {
#pragma unroll
    for (int s = 0; s < 2; ++s) { u32x4 w; w.x = cvtpk(p[8 * s], p[8 * s + 1]); w.y = cvtpk(p[8 * s + 2], p[8 * s + 3]); w.z = cvtpk(p[8 * s + 4], p[8 * s + 5]); w.w = cvtpk(p[8 * s + 6], p[8 * s + 7]);
        pw[s] = __builtin_bit_cast(bf16x8, w); }
}
__device__ __forceinline__ void softmax_step(f32x16& p, float& m, float& zl, f32x16 (&o)[2]) {
    float tm = fmaxf(fmaxf(p[0], p[1]), fmaxf(p[2], p[3]));
#pragma unroll
    for (int r = 4; r < 16; r += 4) tm = fmaxf(tm, fmaxf(fmaxf(p[r], p[r + 1]), fmaxf(p[r + 2], p[r + 3])));
    { const auto rr = __builtin_amdgcn_permlane32_swap(__float_as_uint(tm), __float_as_uint(tm), false, false); tm = fmaxf(__uint_as_float(rr[0]), __uint_as_float(rr[1])); }
    if (__any(tm > m + 8.0f)) {
        const float mn = fmaxf(m, tm), al = __builtin_amdgcn_exp2f(m - mn); m = mn;
        zl *= al;
#pragma unroll
        for (int d0 = 0; d0 < 2; ++d0)
#pragma unroll
            for (int r = 0; r < 16; ++r) o[d0][r] *= al;
    }
    float s = 0.f;
#pragma unroll
    for (int r = 0; r < 16; ++r) { p[r] = __builtin_amdgcn_exp2f(p[r] - m); s += p[r]; }
    zl += s;
}
__device__ __forceinline__ void store_o(const f32x16 (&o)[2], float scale, bf16_t* orow, int hi) {
#pragma unroll
    for (int d0 = 0; d0 < 2; ++d0)
#pragma unroll
        for (int g = 0; g < 4; ++g) { u32x2 w; w.x = cvtpk(o[d0][4 * g] * scale, o[d0][4 * g + 1] * scale); w.y = cvtpk(o[d0][4 * g + 2] * scale, o[d0][4 * g + 3] * scale);
            *(u32x2*)(orow + 32 * d0 + 8 * g + 4 * hi) = w; }
}

template <bool DRY = false> __device__ __forceinline__ void sb_unit(int id, const bf16_t* QKV, bf16_t* OC, ATT_LAS unsigned char* vst, int lane) {
    asm volatile("" : "+v"(lane));
    const int bh = id >> 8, qt = id & 255, b = bh / 6, h = bh - 6 * b, t0 = qt * 32, i = lane & 31, hi = lane >> 5;
    const size_t HS = (size_t)M * 64;
    const bf16_t* base = QKV + (size_t)h * HS + (size_t)b * S * 64;
    bf16x8 qf[4]; load_frag4(qf, base + (size_t)(t0 + i) * 64, hi);
    f32x16 o[2];
#pragma unroll
    for (int r = 0; r < 16; ++r) { o[0][r] = 0.f; o[1][r] = 0.f; }
    ATT_LAS const unsigned char* vb = vst + KSTAGE + (4 * hi + ((lane & 15) >> 2)) * VSTRIDE + ((lane >> 4) & 1) * 32 + (lane & 3) * 8;
    float c = 0.f;
#define SB_LOAD(T_, k_) load_tile(T_, [&](int r) { return base + 6 * HS + (size_t)((k_) + r) * 64; }, [&](int r) { return base + 12 * HS + (size_t)((k_) + r) * 64; }, lane)
    auto tile = [&](const int k0, TileRegs& tr, const int knext) __attribute__((always_inline)) -> bool {
        asm volatile("s_waitcnt lgkmcnt(0)" ::: "memory");
        stage_tile(vst, tr, lane);
        if (knext >= 0 && !DRY) SB_LOAD(tr, knext);
        asm volatile("s_waitcnt lgkmcnt(0)" ::: "memory");
        bf16x8 kf[4], vf[2][2]; read_kfrag(kf, vst, lane); read_vfrag(vf, vb);
        f32x16 z = qk_tile(kf, qf);
        float w[16];
        const bool diag = (k0 == t0);
#pragma unroll
        for (int r = 0; r < 16; ++r) { const float zz = z[r], e = __builtin_amdgcn_exp2f(-fabsf(zz)), l2 = __builtin_amdgcn_logf(1.0f + e);
            w[r] = fmaxf(zz, 0.f) + l2; z[r] = fminf(zz, 0.f) - l2; }
        if (diag) { int ii = i - 4 * hi; asm volatile("" : "+v"(ii));
#pragma unroll
            for (int r = 0; r < 16; ++r) if (!((r & 3) + 8 * (r >> 2) < ii)) { w[r] = 0.f; z[r] = NEG; } }
        float a[16], T[4], Tp[4];
#pragma unroll
        for (int g = 0; g < 4; ++g) { a[4 * g + 3] = 0.f; a[4 * g + 2] = w[4 * g + 3]; a[4 * g + 1] = a[4 * g + 2] + w[4 * g + 2]; a[4 * g] = a[4 * g + 1] + w[4 * g + 1]; T[g] = a[4 * g] + w[4 * g]; }
#pragma unroll
        for (int g = 0; g < 4; ++g) { const auto rr = __builtin_amdgcn_permlane32_swap(__float_as_uint(T[g]), __float_as_uint(T[g]), false, false); Tp[g] = __uint_as_float(hi == 0 ? rr[1] : rr[0]); }
        const float p3 = T[3] + Tp[3], p2 = T[2] + Tp[2], p1 = T[1] + Tp[1], p0 = T[0] + Tp[0];
        float cum[4]; cum[3] = 0.f; cum[2] = p3; cum[1] = p3 + p2; cum[0] = cum[1] + p1; const float total = cum[0] + p0;
        f32x16 p;
#pragma unroll
        for (int g = 0; g < 4; ++g) { const float bg = c - cum[g] - (hi == 0 ? Tp[g] : 0.f);
#pragma unroll
            for (int j = 0; j < 4; ++j) p[4 * g + j] = __builtin_amdgcn_exp2f(z[4 * g + j] + (bg - a[4 * g + j])); }
        c -= total;
        bf16x8 pw[2]; pack_p(pw, p);
        pv_mma(o, vf, pw);
        return k0 < 32 || __all(c < -150.0f);
    };
    TileRegs ta, tb;
    SB_LOAD(ta, t0); if (t0 >= 32) SB_LOAD(tb, t0 - 32);
#pragma unroll 1
    for (int k0 = t0; ; k0 -= 64) {
        if (tile(k0, ta, k0 - 64)) break;
        if (tile(k0 - 32, tb, k0 - 96)) break;
    }
#undef SB_LOAD
    store_o(o, 1.0f, OC + (size_t)(DRY ? ((b * S + t0 + i) & 4095) : (b * S + t0 + i)) * NOC + h * 64, hi);
}

__device__ __forceinline__ void dil_tile(int T, int& g, int& kt) { if (T < 5) { g = 2; kt = T; } else if (T < 13) { g = 1; kt = T - 5; } else { g = 0; kt = T - 13; } }
template <bool DRY = false> __device__ __forceinline__ void dil_unit(int id, const bf16_t* QKV, bf16_t* OC, ATT_LAS const float* tbl, ATT_LAS unsigned char* vst, int lane) {
    asm volatile("" : "+v"(lane));
    const int b = id >> 9, hh = (id >> 8) & 1, blk = (id >> 4) & 15, res = id & 15, i = lane & 31, hi = lane >> 5;
    const int tb = 512 * blk + res, tq = tb + 16 * i;
    const size_t HS = (size_t)M * 64;
    const bf16_t* base = QKV + (size_t)b * S * 64;
    f32x16 o[2];
#pragma unroll
    for (int r = 0; r < 16; ++r) { o[0][r] = 0.f; o[1][r] = 0.f; }
    ATT_LAS const unsigned char* vb = vst + KSTAGE + (4 * hi + ((lane & 15) >> 2)) * VSTRIDE + ((lane >> 4) & 1) * 32 + (lane & 3) * 8;
    float m = NEG, zl = 0.f;
    bf16x8 qf[4];
#define DIL_LOAD(R_, T_) do { int g_, kt_; dil_tile((T_), g_, kt_); const int sh_ = 2 * g_, hd_ = 2 * g_ + hh, rg_ = tb & ((1 << sh_) - 1), Jt_ = (tb >> sh_) - 128 + 32 * kt_, Jm_ = (S >> sh_) - 1; \
        auto krow_ = [&](int r) { int J_ = Jt_ + r; J_ = J_ < 0 ? 0 : J_; J_ = J_ > Jm_ ? Jm_ : J_; return base + (size_t)(24 + hd_) * HS + (size_t)(rg_ + (J_ << sh_)) * 64; }; \
        load_tile(R_, krow_, [&](int r) { return krow_(r) + 6 * HS; }, lane); } while (0)
    int gprev = -1;
    auto tile = [&](const int T, TileRegs& tr) __attribute__((always_inline)) {
        int g, kt; dil_tile(T, g, kt);
        const int sh = 2 * g, sq = 16 >> sh, Jt0 = (tb >> sh) - 128 + 32 * kt;
        if (g != gprev) { load_frag4(qf, base + (size_t)(18 + 2 * g + hh) * HS + (size_t)tq * 64, hi); gprev = g; }
        const bool skip = Jt0 + 31 < 0;
        asm volatile("s_waitcnt lgkmcnt(0)" ::: "memory");
        if (!skip) stage_tile(vst, tr, lane);
        if (T + 2 < 33 && !DRY) DIL_LOAD(tr, T + 2);
        if (skip) return;
        ATT_LAS const float* tb_g = tbl + (g * 2 + hh) * TBLN + 1;
        asm volatile("s_waitcnt lgkmcnt(0)" ::: "memory");
        bf16x8 kf[4], vf[2][2]; read_kfrag(kf, vst, lane); read_vfrag(vf, vb);
        f32x16 p = qk_tile(kf, qf);
        const int tb0 = (int)(unsigned)(unsigned long long)(ATT_LAS const unsigned char*)tb_g, c4 = tb0 + 4 * (sq * i + 128 - 32 * kt - 4 * hi), lo4 = tb0 - 4, hi4 = tb0 + 4 * 129;
        float bvs[16];
#pragma unroll
        for (int r = 0; r < 16; ++r) { int a4 = c4 - 4 * ((r & 3) + 8 * (r >> 2)); a4 = a4 < lo4 ? lo4 : a4; a4 = a4 > hi4 ? hi4 : a4; bvs[r] = *(ATT_LAS const float*)(ATT_LAS const unsigned char*)(unsigned long long)(unsigned)a4; }
        if (Jt0 < 0) {
#pragma unroll
            for (int r = 0; r < 16; ++r) if (Jt0 + 4 * hi + (r & 3) + 8 * (r >> 2) < 0) bvs[r] = NEG; }
#pragma unroll
        for (int r = 0; r < 16; ++r) p[r] += bvs[r];
        softmax_step(p, m, zl, o);
        bf16x8 pw[2]; pack_p(pw, p);
        pv_mma(o, vf, pw);
    };
    TileRegs ta, tbq;
    DIL_LOAD(ta, 0); DIL_LOAD(tbq, 1);
#pragma unroll 1
    for (int T = 0; T < 33; T += 2) {
        tile(T, ta);
        if (T + 1 < 33) tile(T + 1, tbq);
    }
#undef DIL_LOAD
    float Z; { const auto rr = __builtin_amdgcn_permlane32_swap(__float_as_uint(zl), __float_as_uint(zl), false, false); Z = __uint_as_float(rr[0]) + __uint_as_float(rr[1]); }
    store_o(o, 1.0f / Z, OC + (size_t)(DRY ? ((b * S + tq) & 4095) : (b * S + tq)) * NOC + 384 + hh * 64, hi);
}

__device__ __forceinline__ void dilg_unit(int b, int hh, int g, int r, int jt, const bf16_t* QKV, bf16_t* PART, float* LSE, ATT_LAS const float* tbl, ATT_LAS unsigned char* vst, int lane) {
    asm volatile("" : "+v"(lane));
    const int i = lane & 31, hi = lane >> 5, sh = 2 * g, J0 = 32 * jt, Jm = (S >> sh) - 1;
    const size_t HS = (size_t)M * 64;
    const bf16_t* kbase = QKV + (size_t)(24 + 2 * g + hh) * HS + (size_t)b * S * 64;
    const int tq = r + ((J0 + i) << sh);
    bf16x8 qf[4]; load_frag4(qf, kbase - 6 * HS + (size_t)tq * 64, hi);
    f32x16 o[2];
#pragma unroll
    for (int q = 0; q < 16; ++q) { o[0][q] = 0.f; o[1][q] = 0.f; }
    ATT_LAS const unsigned char* vb = vst + KSTAGE + (4 * hi + ((lane & 15) >> 2)) * VSTRIDE + ((lane >> 4) & 1) * 32 + (lane & 3) * 8;
    ATT_LAS const float* tb_g = tbl + (g * 2 + hh) * TBLN + 1;
    const int tb0 = (int)(unsigned)(unsigned long long)(ATT_LAS const unsigned char*)tb_g, lo4 = tb0 - 4, hi4 = tb0 + 4 * 129;
    float m = NEG, zl = 0.f;
#define DG_LOAD(R_, kt_) do { const int Jt_ = J0 - 128 + 32 * (kt_); \
        auto krow_ = [&](int q) { int J_ = Jt_ + q; J_ = J_ < 0 ? 0 : J_; J_ = J_ > Jm ? Jm : J_; return kbase + (size_t)(r + (J_ << sh)) * 64; }; \
        load_tile(R_, krow_, [&](int q) { return krow_(q) + 6 * HS; }, lane); } while (0)
    auto tile = [&](const int kt, TileRegs& tr) __attribute__((always_inline)) {
        const int Jt0 = J0 - 128 + 32 * kt;
        const bool skip = Jt0 + 31 < 0;
        asm volatile("s_waitcnt lgkmcnt(0)" ::: "memory");
        if (!skip) stage_tile(vst, tr, lane);
        if (kt + 2 < 5) DG_LOAD(tr, kt + 2);
        if (skip) return;
        asm volatile("s_waitcnt lgkmcnt(0)" ::: "memory");
        bf16x8 kf[4], vf[2][2]; read_kfrag(kf, vst, lane); read_vfrag(vf, vb);
        f32x16 p = qk_tile(kf, qf);
        const int c4 = tb0 + 4 * (i + 128 - 32 * kt - 4 * hi);
        float bvs[16];
#pragma unroll
        for (int q = 0; q < 16; ++q) { int a4 = c4 - 4 * ((q & 3) + 8 * (q >> 2)); a4 = a4 < lo4 ? lo4 : a4; a4 = a4 > hi4 ? hi4 : a4; bvs[q] = *(ATT_LAS const float*)(ATT_LAS const unsigned char*)(unsigned long long)(unsigned)a4; }
        if (Jt0 < 0) {
#pragma unroll
            for (int q = 0; q < 16; ++q) if (Jt0 + 4 * hi + (q & 3) + 8 * (q >> 2) < 0) bvs[q] = NEG; }
#pragma unroll
        for (int q = 0; q < 16; ++q) p[q] += bvs[q];
        softmax_step(p, m, zl, o);
        bf16x8 pw[2]; pack_p(pw, p);
        pv_mma(o, vf, pw);
    };
    TileRegs ta, tbq;
    DG_LOAD(ta, 0); DG_LOAD(tbq, 1);
    tile(0, ta); tile(1, tbq); tile(2, ta); tile(3, tbq); tile(4, ta);
#undef DG_LOAD
    float Z; { const auto rr = __builtin_amdgcn_permlane32_swap(__float_as_uint(zl), __float_as_uint(zl), false, false); Z = __uint_as_float(rr[0]) + __uint_as_float(rr[1]); }
    const size_t row = (size_t)b * S + tq;
    store_o(o, 1.0f / Z, PART + ((size_t)g * M + row) * 128 + hh * 64, hi);
    if (hi == 0) LSE[((size_t)g * M + row) * 2 + hh] = m + __builtin_amdgcn_logf(Z);
}
__device__ __forceinline__ void dil_combine(int b, int hh, int t0, int ntok, const bf16_t* PART, const float* LSE, bf16_t* OC, int lane) {
#pragma unroll 2
    for (int k = 0; k < ntok; k += 8) { const size_t row = (size_t)b * S + t0 + k + (lane >> 3);
        float l[3]; u32x4 pv[3];
#pragma unroll
        for (int g = 0; g < 3; ++g) { l[g] = LSE[((size_t)g * M + row) * 2 + hh]; pv[g] = *(const u32x4*)(PART + ((size_t)g * M + row) * 128 + hh * 64 + (lane & 7) * 8); }
        const float mx = fmaxf(fmaxf(l[0], l[1]), l[2]); float w[3], ws = 0.f;
#pragma unroll
        for (int g = 0; g < 3; ++g) { w[g] = __builtin_amdgcn_exp2f(l[g] - mx); ws += w[g]; }
        const float rz = __builtin_amdgcn_rcpf(ws); float acc[8];
#pragma unroll
        for (int e = 0; e < 8; ++e) acc[e] = 0.f;
#pragma unroll
        for (int g = 0; g < 3; ++g) { const float wg = w[g] * rz; const unsigned d4[4] = {pv[g].x, pv[g].y, pv[g].z, pv[g].w};
#pragma unroll
            for (int e = 0; e < 4; ++e) { acc[2 * e] += wg * __uint_as_float(d4[e] << 16); acc[2 * e + 1] += wg * __uint_as_float(d4[e] & 0xffff0000u); } }
        u32x4 o; o.x = cvtpk(acc[0], acc[1]); o.y = cvtpk(acc[2], acc[3]); o.z = cvtpk(acc[4], acc[5]); o.w = cvtpk(acc[6], acc[7]);
        *(u32x4*)(OC + row * NOC + 384 + hh * 64 + (lane & 7) * 8) = o; }
}

__device__ __forceinline__ void mem_unit(int id, const bf16_t* QKV, const bf16_t* MK, const bf16_t* MV, bf16_t* OC, ATT_LAS unsigned char* vst, int lane) {
    asm volatile("" : "+v"(lane));
    const int b = id >> 10, head = (id >> 8) & 3, qt = id & 255, t0 = qt * 32, i = lane & 31, hi = lane >> 5;
    bf16x8 qf[4]; load_frag4(qf, QKV + ((size_t)(36 + head) * M + (b * S + t0 + i)) * 64, hi);
    f32x16 o[2];
#pragma unroll
    for (int r = 0; r < 16; ++r) { o[0][r] = 0.f; o[1][r] = 0.f; }
    ATT_LAS const unsigned char* vb = vst + KSTAGE + (4 * hi + ((lane & 15) >> 2)) * VSTRIDE + ((lane >> 4) & 1) * 32 + (lane & 3) * 8;
    float m = NEG, zl = 0.f;
    const bf16_t* kb = MK + (size_t)(b * NMEM) * 256 + head * 64; const bf16_t* vbs = MV + (size_t)(b * NMEM) * 256 + head * 64;
    TileRegs tn;
    load_tile(tn, [&](int r) { return kb + (size_t)r * 256; }, [&](int r) { return vbs + (size_t)r * 256; }, lane);
#pragma unroll 1
    for (int kt = 0; kt < 8; ++kt) {
        const TileRegs tc = tn;
        if (kt + 1 < 8) { const int mn = 32 * (kt + 1); load_tile(tn, [&](int r) { return kb + (size_t)(mn + r) * 256; }, [&](int r) { return vbs + (size_t)(mn + r) * 256; }, lane); }
        asm volatile("s_waitcnt lgkmcnt(0)" ::: "memory");
        stage_tile(vst, tc, lane);
        asm volatile("s_waitcnt lgkmcnt(0)" ::: "memory");
        bf16x8 kf[4], vf[2][2]; read_kfrag(kf, vst, lane); read_vfrag(vf, vb);
        f32x16 p = qk_tile(kf, qf);
        softmax_step(p, m, zl, o);
        bf16x8 pw[2]; pack_p(pw, p);
        pv_mma(o, vf, pw);
    }
    float Z; { const auto rr = __builtin_amdgcn_permlane32_swap(__float_as_uint(zl), __float_as_uint(zl), false, false); Z = __uint_as_float(rr[0]) + __uint_as_float(rr[1]); }
    store_o(o, 1.0f / Z, OC + (size_t)(b * S + t0 + i) * NOC + 512 + head * 64, hi);
}
}

constexpr int RING_OFF = 0, RING_BYTES = 131072;
constexpr int LDSCTL_OFF = RING_BYTES, MISC_OFF = LDSCTL_OFF + 320;
constexpr int LDS_BYTES = 147456;
static_assert(att::LDS_BYTES <= RING_BYTES && pg8::STAGE_BYTES <= RING_BYTES && MISC_OFF + 128 <= LDS_BYTES, "LDS map");
#define GAS __attribute__((address_space(1)))
#define LAS __attribute__((address_space(3)))
typedef unsigned v4u __attribute__((ext_vector_type(4)));
typedef float f32x4 __attribute__((ext_vector_type(4)));
typedef GAS unsigned gu32;
#define LDS_WAIT() asm volatile("s_waitcnt lgkmcnt(0)" ::: "memory")
constexpr int CW_BAR = 4096;
#define XB_TMO      128
#define XB_XCNT(j)  (256  + 64 * (j))
#define XB_XSUB(j)  (1280 + 64 * (j))
#define XB_XGEN(j)  (2304 + 64 * (j))
#define XB_TOP      3328
#define XB_TOPGEN   3392
#define XCD_BAR_WORDS 3456
#define XB_SPIN_CAP (1u << 18)

__device__ __forceinline__ unsigned xb_ld(unsigned* p)              { return __hip_atomic_load(p, __ATOMIC_RELAXED, __HIP_MEMORY_SCOPE_AGENT); }
__device__ __forceinline__ unsigned xb_add(unsigned* p, unsigned v) { return __hip_atomic_fetch_add(p, v, __ATOMIC_RELAXED, __HIP_MEMORY_SCOPE_AGENT); }
__device__ __forceinline__ unsigned xb_xcc_id() { return (unsigned)__builtin_amdgcn_s_getreg((3 << 11) | 20) & 0xFu; }
#define XB_SPIN(cond, bar) do { unsigned _sp = 0; while (cond) { __builtin_amdgcn_s_sleep(1); \
    if ((++_sp & 255u) == 0u) { if (xb_ld(&(bar)[XB_TMO])) break; if (_sp > XB_SPIN_CAP) { atomicAdd(&(bar)[XB_TMO], 1u); break; } } } } while (0)

struct XcdBarrier {
    int wave; unsigned* bar; unsigned x;
    volatile LAS unsigned* st;
};

__device__ __forceinline__ bool xb_thread0(int wave) { int ln; asm volatile("v_mbcnt_lo_u32_b32 %0, -1, 0\n\tv_mbcnt_hi_u32_b32 %0, -1, %0" : "=v"(ln)); return ln == 0 && wave == 0; }
__device__ __forceinline__ XcdBarrier xcd_barrier_post(unsigned* bar, volatile LAS unsigned* st, int wave) {
    XcdBarrier b; b.wave = wave; b.bar = bar; b.x = xb_xcc_id(); b.st = st;
    if (xb_thread0(wave)) (void)xb_add(&bar[XB_XCNT(b.x)], 1u);
    return b;
}
__device__ __forceinline__ void xcd_barrier_complete(unsigned* bar, unsigned x, unsigned& nloc, unsigned& nx) {
    const unsigned G = gridDim.x * gridDim.y * gridDim.z;
    unsigned sum, cnt, mine, sp = 0u;
    for (;;) {
        sum = 0u; cnt = 0u; mine = 0u;
#pragma unroll
        for (unsigned j = 0; j < 16; ++j) { const unsigned c = xb_ld(&bar[XB_XCNT(j)]); sum += c; cnt += (c > 0u) ? 1u : 0u; mine = (j == x) ? c : mine; }
        if (sum == G) break;
        __builtin_amdgcn_s_sleep(1);
        if ((++sp & 255u) == 0u) { if (xb_ld(&bar[XB_TMO])) break; if (sp > XB_SPIN_CAP) { atomicAdd(&bar[XB_TMO], 1u); break; } }
    }
    nloc = mine > 0u ? mine : 1u; nx = cnt > 0u ? cnt : 1u;
}

__device__ __forceinline__ void xcd_barrier(const XcdBarrier& b) {
    asm volatile("s_waitcnt vmcnt(0)" ::: "memory");
    __syncthreads();
    if (xb_thread0(b.wave)) {
        unsigned* bar = b.bar;
        __builtin_amdgcn_s_waitcnt(0);
        unsigned nloc = b.st[0], nx = b.st[1];
        if (nloc == 0u) { xcd_barrier_complete(bar, b.x, nloc, nx); b.st[0] = nloc; b.st[1] = nx; }
        const unsigned old = xb_add(&bar[XB_XSUB(b.x)], 1u);
        const unsigned gen = old / nloc;
        if (old + 1u == (gen + 1u) * nloc) {
            __builtin_amdgcn_fence(__ATOMIC_RELEASE, "agent");
            asm volatile("s_waitcnt vmcnt(0)" ::: "memory");
            const unsigned og = xb_add(&bar[XB_TOP], 1u);
            const unsigned tg = og / nx;
            if (og + 1u == (tg + 1u) * nx) xb_add(&bar[XB_TOPGEN], 1u);
            else XB_SPIN(xb_ld(&bar[XB_TOPGEN]) == tg, bar);
            __builtin_amdgcn_fence(__ATOMIC_ACQUIRE, "agent");
            xb_add(&bar[XB_XGEN(b.x)], 1u);
            asm volatile("s_waitcnt vmcnt(0)" ::: "memory");
        } else {
            XB_SPIN(xb_ld(&bar[XB_XGEN(b.x)]) == gen, bar);
            __builtin_amdgcn_fence(__ATOMIC_ACQUIRE, "agent");
            asm volatile("s_waitcnt vmcnt(0)" ::: "memory");
        }
    }
    __syncthreads();

}

#ifndef PROBE_SEL
#define PROBE_SEL(b) true
#endif
#ifndef EXTRA_BAR
#define EXTRA_BAR 0
#endif
#ifndef PROBE_BLOCK
#define PROBE_BLOCK 255
#endif
#ifndef PROBE_P0
#define PROBE_P0 0
#endif
#define P0_PROBE_BEGIN(k) unsigned long long pp0_##k = 0; if (PROBE_P0 == k) pp0_##k = __builtin_amdgcn_s_memrealtime()
#define P0_PROBE_END(k) do { if (PROBE_P0 == k) { const unsigned long long t1_ = __builtin_amdgcn_s_memrealtime(), d_ = t1_ - pp0_##k; while (__builtin_amdgcn_s_memrealtime() - t1_ < d_) __builtin_amdgcn_s_sleep(8); } } while (0)
struct Frame {
    LAS unsigned char* lds;
    volatile LAS unsigned* MISC;
    gu32* ctl;
    int wave, vcu, G;
};
__device__ __forceinline__ int lane_now() { int ln; asm volatile("v_mbcnt_lo_u32_b32 %0, -1, 0\n\tv_mbcnt_hi_u32_b32 %0, -1, %0" : "=v"(ln)); return ln; }

__device__ __forceinline__ unsigned pk2(float lo, float hi) { return (unsigned)f2bf(lo) | ((unsigned)f2bf(hi) << 16); }
__device__ __forceinline__ int dest_row(int kind, int n0) {
    if (kind == 1) return n0 < FF ? (n0 >> 7) * 256 + (n0 & 127) : ((n0 - FF) >> 7) * 256 + 128 + ((n0 - FF) & 127);
    if (kind == 2) { const int l = n0 & 255;
        if (n0 < NQKV) return (n0 & ~255) + (((l >> 5) & 1) << 7) + ((l >> 6) << 5) + (l & 31);
        return (n0 & ~255) + (((l >> 3) & 1) << 7) + ((l >> 6) << 5) + (((l >> 4) & 3) << 3) + (l & 7); }
    return n0;
}
__device__ __forceinline__ void p0_item_load(f32x4 (&v)[8], const float* W, const float* gain, int N, int item, int lane) {
    const int nblk = N / 32, kb = item / nblk, nb = item % nblk, k0 = 64 * kb, n0 = 32 * nb;
#pragma unroll
    for (int i = 0; i < 8; ++i) { const int kk = 8 * i + (lane >> 3); const float g = gain ? gain[k0 + kk] : 1.0f;
        v[i] = __builtin_nontemporal_load((const GAS f32x4*)(W + (size_t)(k0 + kk) * N + n0 + 4 * (lane & 7))) * g; }
}
__device__ __forceinline__ void p0_item_finish(const f32x4 (&v)[8], int N, bf16_t* WT, int kind, int ldk, int koff, LAS float* scr, int item, int lane) {
    const int nblk = N / 32, kb = item / nblk, nb = item % nblk, k0 = 64 * kb, n0 = 32 * nb;
#pragma unroll
    for (int i = 0; i < 8; ++i) { LAS float* d = scr + (8 * i + (lane >> 3)) * 33 + 4 * (lane & 7); d[0] = v[i].x; d[1] = v[i].y; d[2] = v[i].z; d[3] = v[i].w; }
    LDS_WAIT(); asm volatile("" ::: "memory");
    const int c = lane & 7;
#pragma unroll
    for (int j = 0; j < 4; ++j) { const int n = (lane >> 3) + 8 * j, r0 = dest_row(kind, n0 + 8 * j) - 8 * j; const LAS float* s = scr + (8 * c) * 33 + n;
        v4u o; o.x = pk2(s[0 * 33], s[1 * 33]); o.y = pk2(s[2 * 33], s[3 * 33]); o.z = pk2(s[4 * 33], s[5 * 33]); o.w = pk2(s[6 * 33], s[7 * 33]);
        *(GAS v4u*)(WT + (size_t)(r0 + n) * ldk + koff + k0 + 8 * c) = o; }
    LDS_WAIT(); asm volatile("" ::: "memory");
}
__device__ __forceinline__ float wave_sum(float v) {
#pragma unroll
    for (int o = 1; o < 64; o <<= 1) v += __shfl_xor(v, o);
    return v;
}
__device__ __forceinline__ void p0_row(const float* xrow, bf16_t* orow, float* rstd, int lane) {
    const GAS f32x4* xr = (const GAS f32x4*)xrow + lane;
    f32x4 v[4]; float s = 0.f;
#pragma unroll
    for (int j = 0; j < 4; ++j) { v[j] = xr[64 * j]; s += (v[j].x * v[j].x + v[j].y * v[j].y) + (v[j].z * v[j].z + v[j].w * v[j].w); }
    s = wave_sum(s);
    GAS unsigned long long* o8 = (GAS unsigned long long*)orow + lane;
#pragma unroll
    for (int j = 0; j < 4; ++j) o8[64 * j] = (unsigned long long)pk2(v[j].x, v[j].y) | ((unsigned long long)pk2(v[j].z, v[j].w) << 32);
    if (lane == 0) *rstd = 1.0f / sqrtf(s * (1.0f / D) + EPS);
}
#ifndef USE_FOLD
#define USE_FOLD 0
#endif
#ifndef P4_REP_DIL
#define P4_REP_DIL 0
#endif
#ifndef P4_REP_MEM
#define P4_REP_MEM 0
#endif
#ifndef P4_REP_SB
#define P4_REP_SB 0
#endif
#ifndef P5_REP
#define P5_REP 0
#endif
#ifndef P0_REP_T
#define P0_REP_T 0
#endif
#ifndef P0_REP_R
#define P0_REP_R 0
#endif
struct WItem { const float* W; const float* gain; bf16_t* WT; int K, N, kind, ldk, koff; };
__device__ __forceinline__ void p0_prologue(Frame& F, const Ptrs& P) {
    unsigned char* ws = P.ws; const int lane_ = lane_now(), tid_ = F.wave * 64 + lane_;
    P0_PROBE_BEGIN(1);
    for (int u = F.vcu; u < 256; u += F.G) {
        typedef short bf16x8_t __attribute__((ext_vector_type(8))); typedef float f32x16_t __attribute__((ext_vector_type(16)));
        const int rg = u >> 3, hd = u & 7, head = hd & 3, r0 = rg * 32, kb = 128 * F.wave, mi = lane_ & 31, hi = lane_ >> 5;
        LAS float* part = (LAS float*)(F.lds + F.wave * 16384);
        f32x4 av[8][2], gv[8][2]; float wv[8][2][8];
        const float* mrow = P.mem + (size_t)(r0 + mi) * D + kb + 8 * hi; const float* grow = P.mem_norm + kb + 8 * hi;
        const float* wp = P.w_mem_kv + (size_t)(kb + 8 * hi) * 512 + hd * 64 + mi;
#pragma unroll
        for (int s = 0; s < 8; ++s) { av[s][0] = *(const GAS f32x4*)(mrow + 16 * s); av[s][1] = *(const GAS f32x4*)(mrow + 16 * s + 4); gv[s][0] = *(const GAS f32x4*)(grow + 16 * s); gv[s][1] = *(const GAS f32x4*)(grow + 16 * s + 4);
#pragma unroll
            for (int t = 0; t < 2; ++t)
#pragma unroll
                for (int j = 0; j < 8; ++j) wv[s][t][j] = wp[(size_t)(16 * s + j) * 512 + 32 * t]; }
        f32x16_t acc[2]; float sq = 0.f;
#pragma unroll
        for (int r = 0; r < 16; ++r) { acc[0][r] = 0.f; acc[1][r] = 0.f; }
#pragma unroll
        for (int s = 0; s < 8; ++s) { const f32x4 a0 = av[s][0], a1 = av[s][1]; sq += (a0.x * a0.x + a0.y * a0.y) + (a0.z * a0.z + a0.w * a0.w) + (a1.x * a1.x + a1.y * a1.y) + (a1.z * a1.z + a1.w * a1.w);
            const f32x4 b0 = a0 * gv[s][0], b1 = a1 * gv[s][1];
            const v4u bw = {pk2(b0.x, b0.y), pk2(b0.z, b0.w), pk2(b1.x, b1.y), pk2(b1.z, b1.w)};
#pragma unroll
            for (int t = 0; t < 2; ++t) { const v4u aw = {pk2(wv[s][t][0], wv[s][t][1]), pk2(wv[s][t][2], wv[s][t][3]), pk2(wv[s][t][4], wv[s][t][5]), pk2(wv[s][t][6], wv[s][t][7])};
                acc[t] = __builtin_amdgcn_mfma_f32_32x32x16_bf16(__builtin_bit_cast(bf16x8_t, aw), __builtin_bit_cast(bf16x8_t, bw), acc[t], 0, 0, 0); } }
#pragma unroll
        for (int t = 0; t < 2; ++t)
#pragma unroll
            for (int r = 0; r < 16; ++r) part[(t * 16 + r) * 64 + lane_] = acc[t][r];
        part[2048 + lane_] = sq;
        __syncthreads();
        if (F.wave == 0) {
            float v[2][16]; float q = 0.f;
#pragma unroll
            for (int t = 0; t < 2; ++t)
#pragma unroll
                for (int r = 0; r < 16; ++r) { float s = 0.f;
#pragma unroll
                    for (int w8 = 0; w8 < 8; ++w8) s += ((const LAS float*)(F.lds + w8 * 16384))[(t * 16 + r) * 64 + lane_];
                    v[t][r] = s; }
#pragma unroll
            for (int w8 = 0; w8 < 8; ++w8) q += ((const LAS float*)(F.lds + w8 * 16384))[2048 + lane_];
            q += __shfl_xor(q, 32);
            const float rs = 1.0f / sqrtf(q * (1.0f / D) + EPS);
            float hs = 0.f;
#pragma unroll
            for (int t = 0; t < 2; ++t)
#pragma unroll
                for (int r = 0; r < 16; ++r) { v[t][r] *= rs; hs += v[t][r] * v[t][r]; }
            hs += __shfl_xor(hs, 32);
            const float hr = 1.0f / sqrtf(hs * (1.0f / HD) + EPS);
            bf16_t* orow = (bf16_t*)(ws + (hd < 4 ? WS_MK : WS_MVT)) + (size_t)(r0 + mi) * 256 + head * 64;
#pragma unroll
            for (int t = 0; t < 2; ++t)
#pragma unroll
                for (int g4 = 0; g4 < 4; ++g4) { const int n0 = 32 * t + 8 * g4 + 4 * hi; float o4[4];
#pragma unroll
                    for (int i = 0; i < 4; ++i) o4[i] = hd < 4 ? v[t][4 * g4 + i] * hr * P.x_k_gain[n0 + i] : v[t][4 * g4 + i];
                    *(unsigned long long*)(orow + n0) = (unsigned long long)pk2(o4[0], o4[1]) | ((unsigned long long)pk2(o4[2], o4[3]) << 32); }
        }
        __syncthreads();
    }
    P0_PROBE_END(1);
    if (F.vcu == 0 && tid_ < 129) { float* BIAS = (float*)(ws + WS_BIAS);
        for (int g = 0; g < 3; ++g) for (int hh = 0; hh < 2; ++hh) BIAS[(g * 2 + hh) * 129 + tid_] = P.rel_bias[T5B[g][tid_] * 6 + g * 2 + hh] * LOG2E; }
    LAS float* scr = (LAS float*)(F.lds + F.wave * 16384);
    const int gw = F.vcu * 8 + F.wave, NGW = F.G * 8;
    const WItem items[9] = {
        {P.ffn1_w_gu, P.ffn1_norm, (bf16_t*)(ws + WS_WGU1), D, NGU, 1, D, 0}, {P.w_in, P.mix_norm, (bf16_t*)(ws + WS_WIN), D, INCOLS, 2, D, 0}, {P.ffn2_w_gu, P.ffn2_norm, (bf16_t*)(ws + WS_WGU2), D, NGU, 1, D, 0},
        {P.ffn1_w_down, nullptr, (bf16_t*)(ws + WS_WD1), FF, D, 0, FF, 0}, {P.ffn2_w_down, nullptr, (bf16_t*)(ws + WS_WD2), FF, D, 0, FF, 0}, {P.w_out, nullptr, (bf16_t*)(ws + WS_WOUT), D, D, 0, D, 0},
        {P.w_br_sb, nullptr, (bf16_t*)(ws + WS_WSB), 384, D, 0, NOC, 0}, {P.w_br_dil, nullptr, (bf16_t*)(ws + WS_WSB), 128, D, 0, NOC, 384}, {P.w_br_x, nullptr, (bf16_t*)(ws + WS_WSB), 256, D, 0, NOC, 512}};
    P0_PROBE_BEGIN(2);
    {
        int cum[10]; cum[0] = 0;
#pragma unroll
        for (int w = 0; w < 9; ++w) cum[w + 1] = cum[w] + (items[w].K / 64) * (items[w].N / 32);
        const int total = cum[9];
        f32x4 va[8], vb[8];
#define P0_LOCATE(G_, w_) int w_ = 0; _Pragma("unroll") for (int q_ = 1; q_ < 9; ++q_) w_ += ((G_) >= cum[q_]) ? 1 : 0
#define P0_LOAD(V_, G_) do { P0_LOCATE(G_, w__); const float* W__ = items[0].W; const float* g__ = items[0].gain; int N__ = items[0].N, c__ = 0; \
            _Pragma("unroll") for (int q_ = 1; q_ < 9; ++q_) if (w__ == q_) { W__ = items[q_].W; g__ = items[q_].gain; N__ = items[q_].N; c__ = cum[q_]; } \
            p0_item_load(V_, W__, g__, N__, (G_) - c__, lane_); } while (0)
#define P0_FINISH(V_, G_) do { P0_LOCATE(G_, w__); bf16_t* T__ = items[0].WT; int N__ = items[0].N, k__ = items[0].kind, l__ = items[0].ldk, o__ = items[0].koff, c__ = 0; \
            _Pragma("unroll") for (int q_ = 1; q_ < 9; ++q_) if (w__ == q_) { T__ = items[q_].WT; N__ = items[q_].N; k__ = items[q_].kind; l__ = items[q_].ldk; o__ = items[q_].koff; c__ = cum[q_]; } \
            p0_item_finish(V_, N__, T__, k__, l__, o__, scr, (G_) - c__, lane_); } while (0)
        int G = gw;
        if (G < total) P0_LOAD(va, G);
        for (; G < total; G += 2 * NGW) {
            if (G + NGW < total) P0_LOAD(vb, G + NGW);
            P0_FINISH(va, G);
            if (G + NGW < total) { if (G + 2 * NGW < total) P0_LOAD(va, G + 2 * NGW); P0_FINISH(vb, G + NGW); }
        }
#undef P0_LOCATE
#undef P0_LOAD
#undef P0_FINISH
    }
    P0_PROBE_END(2);
    P0_PROBE_BEGIN(3);
    for (int m = gw; m < M; m += 4 * NGW) {
        f32x4 v[4][4];
#pragma unroll
        for (int q = 0; q < 4; ++q) { const int mq = (m + q * NGW < M) ? m + q * NGW : m; const GAS f32x4* xr = (const GAS f32x4*)(P.x + (size_t)mq * D) + lane_;
#pragma unroll
            for (int j = 0; j < 4; ++j) v[q][j] = __builtin_nontemporal_load(xr + 64 * j); }
#pragma unroll
        for (int q = 0; q < 4; ++q) { const int mq = m + q * NGW; if (mq < M) { float s = 0.f;
#pragma unroll
            for (int j = 0; j < 4; ++j) s += (v[q][j].x * v[q][j].x + v[q][j].y * v[q][j].y) + (v[q][j].z * v[q][j].z + v[q][j].w * v[q][j].w);
            s = wave_sum(s);
            GAS unsigned long long* o8 = (GAS unsigned long long*)((bf16_t*)(ws + WS_XB) + (size_t)mq * D) + lane_;
#pragma unroll
            for (int j = 0; j < 4; ++j) o8[64 * j] = (unsigned long long)pk2(v[q][j].x, v[q][j].y) | ((unsigned long long)pk2(v[q][j].z, v[q][j].w) << 32);
            if (lane_ == 0) ((float*)(ws + WS_RSTD0))[mq] = 1.0f / sqrtf(s * (1.0f / D) + EPS); } }
    }
    P0_PROBE_END(3);
}

#ifndef PROBE_PHASE
#define PROBE_PHASE -1
#endif
#ifndef REP_MASK
#define REP_MASK 0x0
#endif
constexpr int NPHASE = 9;
struct Args { Ptrs P; int ph_lo, ph_hi, use_bar, rep; };
__global__ void __launch_bounds__(512, 2) mega_fwd(Args args) {
    extern __shared__ __attribute__((aligned(16))) unsigned char lds[];
    Frame F;
    F.lds = (LAS unsigned char*)lds;
    F.MISC = (volatile LAS unsigned*)(F.lds + MISC_OFF);
    F.wave = __builtin_amdgcn_readfirstlane(threadIdx.x >> 6);
    F.G = gridDim.x; { const int bx = blockIdx.x; F.vcu = (F.G % 8 == 0) ? (bx % 8) * (F.G / 8) + bx / 8 : bx; }
    const Ptrs& P = args.P;
    unsigned char* ws = P.ws;
    F.ctl = (gu32*)(ws + WS_CTL);
    for (int u = F.wave * 64 + lane_now(); u < (LDS_BYTES - LDSCTL_OFF) / 4; u += 512) ((LAS unsigned*)(F.lds + LDSCTL_OFF))[u] = 0u;
    __syncthreads();
    XcdBarrier bar; bar.wave = F.wave; bar.bar = (unsigned*)(F.ctl + CW_BAR); bar.x = 0; bar.st = nullptr;
    if (args.use_bar) bar = xcd_barrier_post((unsigned*)(F.ctl + CW_BAR), F.MISC + 8, F.wave);
    const int lo = args.ph_lo, hi = args.ph_hi;
#define IN(k) (lo <= (k) && (k) < hi)
#define SEAM(k) do { if (IN(k) && IN((k) + 1)) { xcd_barrier(bar); if (EXTRA_BAR) xcd_barrier(bar); } PROBE_AT(k); } while (0)
#if PROBE_PHASE >= 0
    unsigned long long pr_t0 = __builtin_amdgcn_s_memrealtime();
#define PROBE_AT(k) do { if ((k) + 1 == PROBE_PHASE) pr_t0 = __builtin_amdgcn_s_memrealtime(); \
        if ((k) == PROBE_PHASE) { if (PROBE_SEL(blockIdx.x)) { const unsigned long long t1_ = __builtin_amdgcn_s_memrealtime(), d_ = t1_ - pr_t0; while (__builtin_amdgcn_s_memrealtime() - t1_ < d_) __builtin_amdgcn_s_sleep(8); __syncthreads(); } } } while (0)
#else
#define PROBE_AT(k) do { } while (0)
#endif
    bf16_t *XB = (bf16_t*)(ws + WS_XB), *OC = (bf16_t*)P.out  , *H = (bf16_t*)(ws + WS_BIG), *QKV = H; unsigned char* G = ws + WS_G;
    bf16_t* MERGED = (bf16_t*)(ws + WS_BIG + 64 * MiB);
    bf16_t* MACC = (bf16_t*)(ws + WS_BIG); float *SS1 = (float*)(ws + WS_SS1), *SS2 = (float*)(ws + WS_SS2), *RSTD0 = (float*)(ws + WS_RSTD0);
    const int cblk = (int)blockIdx.x;

    _Pragma("unroll") for (int rp_ = 0; rp_ <= ((REP_MASK >> 0) & 1); ++rp_) if (IN(0)) { if (rp_) xcd_barrier(bar); p0_prologue(F, P); } SEAM(0);
    _Pragma("unroll") for (int rp_ = 0; rp_ <= ((REP_MASK >> 1) & 1); ++rp_) if (IN(1)) { if (rp_) xcd_barrier(bar); pg8::Gemm g{XB, (const bf16_t*)(ws + WS_WGU1), M, NGU, D, D, D}; pg8::StaticOrder So; So.init(M, NGU, F.G, cblk);
        pg8::EpiFfnUp E{H, RSTD0, nullptr}; pg8::gemm_phase(F.lds, g, So, E, F.wave); } SEAM(1);
    _Pragma("unroll") for (int rp_ = 0; rp_ <= ((REP_MASK >> 2) & 1); ++rp_) if (IN(2)) { if (rp_) xcd_barrier(bar); pg8::Gemm g{H, (const bf16_t*)(ws + WS_WD1), M, D, FF, FF, FF}; pg8::StaticOrder So; So.init(M, D, F.G, cblk);
        pg8::EpiResB E{XB, SS1, 0.5f};   pg8::gemm_phase(F.lds, g, So, E, F.wave); } SEAM(2);
    _Pragma("unroll") for (int rp_ = 0; rp_ <= ((REP_MASK >> 3) & 1); ++rp_) if (IN(3)) { if (rp_) xcd_barrier(bar); pg8::Gemm g{XB, (const bf16_t*)(ws + WS_WIN), M, INCOLS, D, D, D}; pg8::StaticOrder So; So.init(M, INCOLS, F.G, cblk);
        pg8::EpiWin E{QKV, G, SS1, P.dil_q_gain, P.dil_k_gain, P.x_q_gain, nullptr, (bf16_t*)(ws + 57 * MiB)}; pg8::gemm_phase(F.lds, g, So, E, F.wave); } SEAM(3);
    _Pragma("unroll") for (int rp_ = 0; rp_ <= ((REP_MASK >> 4) & 1); ++rp_) if (IN(4)) { if (rp_) xcd_barrier(bar);
        LAS float* tbl = (LAS float*)(F.lds + att::LDS_TBL); const float* BIAS = (const float*)(ws + WS_BIAS); const int lane_ = lane_now();
        for (int e = F.wave * 64 + lane_; e < 6 * att::TBLN; e += 512) { const int t = e / att::TBLN, s = e % att::TBLN; tbl[e] = (s >= 1 && s <= 129) ? BIAS[t * 129 + s - 1] : att::NEG; }
        __syncthreads();
        LAS unsigned char* vst = F.lds + att::LDS_VST + F.wave * att::WSTAGE;
        const int gw = F.vcu * 8 + F.wave, NGW = F.G * 8;
        if (F.G == 256) {
            bf16_t* PART = (bf16_t*)((unsigned char*)P.out + 64 * MiB); float* LSE = (float*)((unsigned char*)P.out + 96 * MiB);
            const bool dilb = F.vcu < 128; const int v2 = F.vcu - 128;
            P0_PROBE_BEGIN(31);
            if (dilb) { const int b = F.vcu >> 5, hh = (F.vcu >> 4) & 1, span = F.vcu & 15;
                for (int k = 0; k < 6; ++k) { const int wu = F.wave + 8 * k;
                    if (wu < 16) att::dilg_unit(b, hh, 0, 0, span * 16 + wu, QKV, PART, LSE, tbl, vst, lane_);
                    else if (wu < 32) att::dilg_unit(b, hh, 1, (wu - 16) & 3, span * 4 + ((wu - 16) >> 2), QKV, PART, LSE, tbl, vst, lane_);
                    else att::dilg_unit(b, hh, 2, wu - 32, span, QKV, PART, LSE, tbl, vst, lane_); }
            }
            P0_PROBE_END(31);
            const int nsb = dilb ? 2 : 4, sb0 = dilb ? F.vcu * 2 : 256 + v2 * 4, nme = dilb ? 1 : 3, me0 = dilb ? F.vcu : 128 + v2 * 3;
            P0_PROBE_BEGIN(32);
            for (int j = 0; j < nme; ++j) att::mem_unit((me0 + j) * 8 + F.wave, QKV, (const bf16_t*)(ws + WS_MK), (const bf16_t*)(ws + WS_MVT), OC, vst, lane_);
            P0_PROBE_END(32);
            P0_PROBE_BEGIN(33);
            for (int j = 0; j < nsb; ++j) att::sb_unit((sb0 + j) * 8 + F.wave, QKV, OC, vst, lane_);
            P0_PROBE_END(33);
            if (dilb) { asm volatile("s_waitcnt vmcnt(0)" ::: "memory"); __syncthreads();
                att::dil_combine(F.vcu >> 5, (F.vcu >> 4) & 1, (F.vcu & 15) * 512 + F.wave * 64, 64, PART, LSE, OC, lane_); }
        } else {
            for (int id = gw; id < 2048; id += NGW) att::dil_unit(id, QKV, OC, tbl, vst, lane_);
            for (int id = gw; id < 4096; id += NGW) att::mem_unit(id, QKV, (const bf16_t*)(ws + WS_MK), (const bf16_t*)(ws + WS_MVT), OC, vst, lane_);
            for (int id = gw; id < 6144; id += NGW) att::sb_unit(id, QKV, OC, vst, lane_);
        }
        asm volatile("s_waitcnt vmcnt(0) lgkmcnt(0)" ::: "memory"); __syncthreads();
    } SEAM(4);
    _Pragma("unroll") for (int rp_ = 0; rp_ <= ((REP_MASK >> 5) & 1); ++rp_) if (IN(5)) { if (rp_) xcd_barrier(bar);
        pg8::ChainOrder<0, 6, 384, 2, 512, 4> So; So.init(M, D, F.G, cblk);
        pg8::Gemm g{OC, (const bf16_t*)(ws + WS_WSB), M, D, NOC, NOC, NOC}; pg8::EpiBranchChain E{G, MACC, MERGED}; pg8::gemm_phase(F.lds, g, So, E, F.wave); } SEAM(5);
    _Pragma("unroll") for (int rp_ = 0; rp_ <= ((REP_MASK >> 6) & 1); ++rp_) if (IN(6)) { if (rp_) xcd_barrier(bar); pg8::Gemm g{MERGED, (const bf16_t*)(ws + WS_WOUT), M, D, D, D, D}; pg8::StaticOrder So; So.init(M, D, F.G, cblk);
        pg8::EpiResB E{XB, SS2, 1.0f}; pg8::gemm_phase(F.lds, g, So, E, F.wave); } SEAM(6);
    _Pragma("unroll") for (int rp_ = 0; rp_ <= ((REP_MASK >> 7) & 1); ++rp_) if (IN(7)) { if (rp_) xcd_barrier(bar); pg8::Gemm g{XB, (const bf16_t*)(ws + WS_WGU2), M, NGU, D, D, D}; pg8::StaticOrder So; So.init(M, NGU, F.G, cblk);
        pg8::EpiFfnUp E{H, nullptr, SS2}; pg8::gemm_phase(F.lds, g, So, E, F.wave); } SEAM(7);
    _Pragma("unroll") for (int rp_ = 0; rp_ <= ((REP_MASK >> 8) & 1); ++rp_) if (IN(8)) { if (rp_) xcd_barrier(bar); pg8::Gemm g{H, (const bf16_t*)(ws + WS_WD2), M, D, FF, FF, FF}; pg8::StaticOrder So; So.init(M, D, F.G, cblk);
        pg8::EpiResOut E{XB, P.out, 0.5f}; pg8::gemm_phase(F.lds, g, So, E, F.wave); }
    PROBE_AT(8);
#undef IN
#undef SEAM
}

extern "C" void kernel_launch(void* const* d_in, const int* in_sizes, int n_in, void* d_out, int out_size, void* d_ws, size_t ws_size, hipStream_t stream) {
    static int grid = 0;
    if (grid == 0) {
        if (n_in != 21 || out_size != M * D || ws_size < WS_END) { fprintf(stderr, "kernel_launch: unexpected shapes (n_in %d out %d ws %zu)\n", n_in, out_size, ws_size); grid = -1; return; }
        int dev = 0, cus = 0, per_cu = 0;
        if (hipGetDevice(&dev) != hipSuccess || hipDeviceGetAttribute(&cus, hipDeviceAttributeMultiprocessorCount, dev) != hipSuccess) { grid = -1; return; }
        if (hipFuncSetAttribute((const void*)mega_fwd, hipFuncAttributeMaxDynamicSharedMemorySize, LDS_BYTES) != hipSuccess) { fprintf(stderr, "kernel_launch: hipFuncSetAttribute failed\n"); grid = -1; return; }
        if (hipOccupancyMaxActiveBlocksPerMultiprocessor(&per_cu, (const void*)mega_fwd, 512, LDS_BYTES) != hipSuccess || per_cu < 1) { fprintf(stderr, "kernel_launch: occupancy query says %d blocks per CU\n", per_cu); grid = -1; (void)hipGetLastError(); return; }
        (void)hipGetLastError();
        grid = cus;
    }
    if (grid < 0) return;
    Args a{};
    { const float** pp = (const float**)&a.P; for (int i = 0; i < 21; ++i) pp[i] = (const float*)d_in[i]; }
    a.P.out = (float*)d_out; a.P.ws = (unsigned char*)d_ws;
    unsigned char* ws = a.P.ws;
    (void)hipMemsetAsync(ws + WS_CTL, 0, CTL_ZERO_BYTES, stream);
    a.ph_lo = 0; a.ph_hi = NPHASE; a.use_bar = 1;
    hipLaunchKernelGGL(mega_fwd, dim3(grid), dim3(512), LDS_BYTES, stream, a);
    return;
}
```

```cpp
#include <hip/hip_runtime.h>
#include <cstdint>
#include <cstdio>

constexpr int NB = 4, S = 8192, D = 1024, M = NB * S;
constexpr int FF = 2816, NGU = 2 * FF;
constexpr int HD = 64;
constexpr int NQKV = 2560, NGATE = 3072, INCOLS = NQKV + NGATE;
constexpr int QKVP = 2624;
constexpr int NMEM = 256, MROWS = NB * NMEM;
constexpr int NOC = 768;
constexpr float EPS = 1e-6f;
constexpr float LOG2E = 1.4426950408889634f;
constexpr float QSCALE = 0.125f * LOG2E;

typedef unsigned short bf16_t;
__device__ __forceinline__ float bf2f(bf16_t v) { return __uint_as_float(((unsigned)v) << 16); }
__device__ __forceinline__ bf16_t f2bf(float f) { unsigned u = __float_as_uint(f); return (bf16_t)((u + 0x7fffu + ((u >> 16) & 1u)) >> 16); }

constexpr size_t MiB = 1u << 20;
constexpr size_t WS_CTL = 0, CTL_ZERO_BYTES = 1 * MiB;
constexpr size_t WS_SS1 = 256 * 1024, WS_SS2 = 384 * 1024, WS_RSTD0 = 512 * 1024, WS_BIAS = 768 * 1024;
constexpr size_t WS_WGU1 = 2 * MiB, WS_WD1 = 13 * MiB, WS_WIN = 19 * MiB, WS_WGU2 = 30 * MiB, WS_WD2 = 41 * MiB, WS_WOUT = 47 * MiB, WS_WSB = 49 * MiB  , WS_WDIL = 51 * MiB, WS_WX = 52 * MiB, WS_WSB2 = 53 * MiB;
constexpr size_t WS_MK = 54 * MiB, WS_MVT = 55 * MiB;
constexpr size_t WS_XB = 64 * MiB;
constexpr size_t WS_BIG = 128 * MiB;
constexpr size_t WS_G = 296 * MiB;
constexpr size_t WS_END = 488 * MiB;
static_assert(WS_WGU1 + (size_t)NGU * D * 2 <= WS_WD1 && WS_WD1 + (size_t)D * FF * 2 <= WS_WIN && WS_WIN + (size_t)INCOLS * D * 2 <= WS_WGU2 && WS_WGU2 + (size_t)NGU * D * 2 <= WS_WD2 &&
              WS_WD2 + (size_t)D * FF * 2 <= WS_WOUT && WS_WOUT + (size_t)D * D * 2 <= WS_WSB && WS_XB + (size_t)M * D * 2 <= WS_BIG && WS_BIG + (size_t)M * QKVP * 2 <= WS_G && WS_G + (size_t)M * NGATE * 2 <= WS_END, "d_ws map");

__device__ const unsigned char T5B[3][129] = {
 {0,1,2,3,4,5,6,7,8,9,10,11,12,13,14,15,16,16,16,16,16,16,17,17,17,17,17,17,17,17,18,18,18,18,18,18,18,18,18,18,19,19,19,19,19,19,19,19,19,19,19,19,19,19,20,20,20,20,20,20,20,20,20,20,20,20,20,20,20,20,20,20,20,21,21,21,21,21,21,21,21,21,21,21,21,21,21,21,21,21,21,21,21,21,21,21,21,21,21,22,22,22,22,22,22,22,22,22,22,22,22,22,22,22,22,22,22,22,22,22,22,22,22,22,22,22,22,22,22},
 {0,4,8,12,16,16,17,17,18,18,19,19,19,19,20,20,20,20,20,21,21,21,21,21,21,22,22,22,22,22,22,22,22,22,23,23,23,23,23,23,23,23,23,23,23,23,24,24,24,24,24,24,24,24,24,24,24,24,24,24,24,24,25,25,25,25,25,25,25,25,25,25,25,25,25,25,25,25,25,25,25,25,25,26,26,26,26,26,26,26,26,26,26,26,26,26,26,26,26,26,26,26,26,26,26,26,26,26,26,26,26,26,26,27,27,27,27,27,27,27,27,27,27,27,27,27,27,27,27},
 {0,16,18,19,20,21,21,22,22,23,23,23,24,24,24,24,25,25,25,25,25,26,26,26,26,26,26,26,26,27,27,27,27,27,27,27,27,27,27,28,28,28,28,28,28,28,28,28,28,28,28,28,29,29,29,29,29,29,29,29,29,29,29,29,29,29,29,29,29,29,30,30,30,30,30,30,30,30,30,30,30,30,30,30,30,30,30,30,30,30,30,30,30,30,30,31,31,31,31,31,31,31,31,31,31,31,31,31,31,31,31,31,31,31,31,31,31,31,31,31,31,31,31,31,31,31,31,31,31}};

struct Ptrs {
    const float *x, *mem, *rel_bias, *ffn1_norm, *ffn1_w_gu, *ffn1_w_down, *mix_norm, *mem_norm, *w_in, *w_mem_kv,
                *dil_q_gain, *dil_k_gain, *x_q_gain, *x_k_gain, *w_br_sb, *w_br_dil, *w_br_x, *w_out, *ffn2_norm, *ffn2_w_gu, *ffn2_w_down;
    float* out; unsigned char* ws;
};

#ifndef PG8_USE_SP2
#define PG8_USE_SP2 1
#endif
namespace pg8 {
#define PG8_LAS __attribute__((address_space(3)))
typedef short bf16x8 __attribute__((ext_vector_type(8)));
typedef float f32x4 __attribute__((ext_vector_type(4)));
typedef float f32x2 __attribute__((ext_vector_type(2)));
typedef unsigned u32x4 __attribute__((ext_vector_type(4)));
typedef unsigned u32x2 __attribute__((ext_vector_type(2)));
constexpr int BM = 256, BK = 64, HALF = 128, HTB = HALF * BK * 2  , STAGE_BYTES = 8 * HTB, NXCD = 8, WGM = 8;

__host__ __device__ __forceinline__ int lds_byte(int r, int c) { const int st = (r >> 4) * 2 + (c >> 5), rr = r & 15, cc = c & 31, ob = rr * 64 + cc * 2; return st * 1024 + (ob ^ (((ob >> 9) & 1) << 5)); }
__host__ __device__ __forceinline__ void stage_rc(int b, int& R, int& C) { const int st = b / 1024, sb = b % 1024, swz = sb ^ (((sb >> 9) & 1) << 5); R = (st >> 1) * 16 + swz / 64; C = (st & 1) * 32 + (swz % 64) / 2; }
__host__ __device__ __forceinline__ int perm32(int rho) { const int n = rho >> 4, i = rho & 15; return 8 * (i >> 2) + 4 * n + (i & 3); }

struct Unit { int pm, pn, koff, ntu, step; };
struct Gemm { const bf16_t* A; const bf16_t* Bt; int M, N, K, lda, ldb; };

struct StaticOrder {
    int nM, nN, nwg, G, c;
    __host__ __device__ void init(int M_, int N_, int G_, int c_) { nM = M_ / BM; nN = N_ / BM; nwg = nM * nN; G = G_; c = c_; }
    __host__ __device__ bool next(int i, Unit& u) const {
        const long L = (long)i * G + c; if (L >= nwg) return false;
        int wgid = (int)L; { const int q = nwg / NXCD, r = nwg % NXCD, xcd = wgid % NXCD, off = wgid / NXCD; wgid = (xcd < r ? xcd * (q + 1) : r * (q + 1) + (xcd - r) * q) + off; }
        const int nig = WGM * nN, gid = wgid / nig, fm = gid * WGM, gsz = (nM - fm) < WGM ? (nM - fm) : WGM;
        u.pm = fm + ((wgid % nig) % gsz); u.pn = (wgid % nig) / gsz; u.koff = 0; u.ntu = 0; u.step = 0; return true;
    }
};

template <int K0, int N0, int K1, int N1, int K2, int N2> struct ChainOrder {
    StaticOrder S; int per;
    __host__ __device__ void init(int M_, int N_, int G_, int c_) { S.init(M_, N_, G_, c_); per = (S.nwg - c_ + G_ - 1) / G_; if (per < 0) per = 0; }
    __host__ __device__ bool next(int i, Unit& u) const { if (per == 0 || i >= 3 * per) return false; int s = 0, j = i; if (j >= per) { j -= per; s = 1; } if (j >= per) { j -= per; s = 2; }
        if (!S.next(j, u)) return false;
        int ko = K0, nu = N0; if (s == 1) { ko = K1; nu = N1; } if (s == 2) { ko = K2; nu = N2; }
        u.koff = ko; u.ntu = nu; u.step = s; return true; }
};

typedef float f32x2_t __attribute__((ext_vector_type(2))); typedef __bf16 bf16x2_t __attribute__((ext_vector_type(2)));
__device__ __forceinline__ unsigned cvt_pk_bf16(float lo, float hi) { const f32x2_t v = {lo, hi}; return __builtin_bit_cast(unsigned, __builtin_convertvector(v, bf16x2_t)); }
__device__ __forceinline__ float fast_sigmoid(float v) { return __builtin_amdgcn_rcpf(1.0f + __builtin_amdgcn_exp2f(-LOG2E * v)); }
__device__ __forceinline__ float sum_fq(float s) {
    const auto a = __builtin_amdgcn_permlane16_swap(__float_as_uint(s), __float_as_uint(s), false, false); s = __uint_as_float(a[0]) + __uint_as_float(a[1]);
    const auto b = __builtin_amdgcn_permlane32_swap(__float_as_uint(s), __float_as_uint(s), false, false); return __uint_as_float(b[0]) + __uint_as_float(b[1]); }
__device__ __forceinline__ void store16_wt(void* ptr, u32x4 v) { asm volatile("global_store_dwordx4 %0, %1, off sc1\n\ts_nop 1" :: "v"(ptr), "v"(v) : "memory"); }
__device__ __forceinline__ unsigned gate_q4(f32x4 v) { unsigned w = 0;
#pragma unroll
    for (int i = 0; i < 4; ++i) w = __builtin_amdgcn_cvt_pk_u8_f32(v[i] * 16.0f + 128.0f, i, w);
    return w; }
__device__ __forceinline__ f32x4 gate_dq4(unsigned w) { f32x4 g;
#pragma unroll
    for (int i = 0; i < 4; ++i) g[i] = ((float)((w >> (8 * i)) & 255u) - 128.0f) * 0.0625f;
    return g; }
__device__ __forceinline__ float row_rstd(const float* rstd, const float* ss, int row) { return rstd ? rstd[row] : __builtin_amdgcn_rsqf(ss[row] * (1.0f / D) + EPS); }

struct RowPre { float r[2][4]; };
struct EpiFfnUp {
    static constexpr bool PERM = true, FOLD = false, EPI_TWICE = false, EPI_DRY = false; static constexpr int TOUCH = 0;
    bf16_t* H; const float* rstd; const float* ss;
    static constexpr bool PRE = true;
    __device__ __forceinline__ RowPre pre(const Unit& u, int wr, int fr) const { RowPre q; const int row0 = u.pm * BM + wr * 64 + fr;
#pragma unroll
        for (int ai = 0; ai < 2; ++ai)
#pragma unroll
            for (int m = 0; m < 4; ++m) q.r[ai][m] = rstd ? rstd[row0 + ai * HALF + m * 16] : ss[row0 + ai * HALF + m * 16];
        return q; }
    __device__ __forceinline__ void operator()(const f32x4 (&acc)[2][2][4][2], const Unit& u, int wr, int wc, int fr, int fq, const RowPre& q) const {
        const int row0 = u.pm * BM + wr * 64 + fr, col0 = u.pn * 128 + wc * 32 + 8 * fq;
#pragma unroll
        for (int ai = 0; ai < 2; ++ai)
#pragma unroll
            for (int m = 0; m < 4; ++m) { const int row = row0 + ai * HALF + m * 16; const float r = rstd ? q.r[ai][m] : __builtin_amdgcn_rsqf(q.r[ai][m] * (1.0f / D) + EPS); float h[8];
#pragma unroll
                for (int n = 0; n < 2; ++n)
#pragma unroll
                    for (int i = 0; i < 4; ++i) { const float a = acc[ai][0][m][n][i] * r, b = acc[ai][1][m][n][i] * r; h[n * 4 + i] = a * fast_sigmoid(a) * b; }
                u32x4 w; w.x = cvt_pk_bf16(h[0], h[1]); w.y = cvt_pk_bf16(h[2], h[3]); w.z = cvt_pk_bf16(h[4], h[5]); w.w = cvt_pk_bf16(h[6], h[7]);
                store16_wt((void*)(H + (size_t)row * FF + col0), w); }
    }
};
struct EpiResOut {
    static constexpr bool PRE = false, PERM = true, FOLD = false, EPI_TWICE = false, EPI_DRY = false; static constexpr int TOUCH = 0;
    const bf16_t* xb; float* out; float alpha;
    __device__ __forceinline__ void operator()(const f32x4 (&acc)[2][2][4][2], const Unit& u, int wr, int wc, int fr, int fq) const {
        const int row0 = u.pm * BM + wr * 64 + fr, col0 = u.pn * BM + wc * 32 + 8 * fq;
        u32x4 rv[2][4][2];
#pragma unroll
        for (int ai = 0; ai < 2; ++ai)
#pragma unroll
            for (int m = 0; m < 4; ++m)
#pragma unroll
                for (int bj = 0; bj < 2; ++bj) rv[ai][m][bj] = *(const u32x4*)(xb + (size_t)(row0 + ai * HALF + m * 16) * D + col0 + bj * HALF);
        asm volatile("" ::: "memory");
#pragma unroll
        for (int ai = 0; ai < 2; ++ai)
#pragma unroll
            for (int m = 0; m < 4; ++m) { float* orow = out + (size_t)(row0 + ai * HALF + m * 16) * D + col0;
#pragma unroll
                for (int bj = 0; bj < 2; ++bj) { const u32x4 r = rv[ai][m][bj];
                    const f32x4 r0 = {__uint_as_float(r.x << 16), __uint_as_float(r.x & 0xffff0000u), __uint_as_float(r.y << 16), __uint_as_float(r.y & 0xffff0000u)};
                    const f32x4 r1 = {__uint_as_float(r.z << 16), __uint_as_float(r.z & 0xffff0000u), __uint_as_float(r.w << 16), __uint_as_float(r.w & 0xffff0000u)};
                    const f32x4 o0 = r0 + acc[ai][bj][m][0] * alpha, o1 = r1 + acc[ai][bj][m][1] * alpha;
                    store16_wt((void*)(orow + bj * HALF), __builtin_bit_cast(u32x4, o0)); store16_wt((void*)(orow + bj * HALF + 4), __builtin_bit_cast(u32x4, o1)); } }
        asm volatile("" ::: "memory");
    }
};
struct EpiResB {
    static constexpr bool PRE = false, PERM = true, FOLD = false, EPI_TWICE = false, EPI_DRY = false; static constexpr int TOUCH = 0;
    bf16_t* xb; float* ss; float alpha;
    __device__ __forceinline__ void operator()(const f32x4 (&acc)[2][2][4][2], const Unit& u, int wr, int wc, int fr, int fq) const {
        const int row0 = u.pm * BM + wr * 64 + fr, col0 = u.pn * BM + wc * 32 + 8 * fq;
        u32x4 rv[2][4][2];
#pragma unroll
        for (int ai = 0; ai < 2; ++ai)
#pragma unroll
            for (int m = 0; m < 4; ++m)
#pragma unroll
                for (int bj = 0; bj < 2; ++bj) rv[ai][m][bj] = *(const u32x4*)(xb + (size_t)(row0 + ai * HALF + m * 16) * D + col0 + bj * HALF);
        asm volatile("" ::: "memory");
#pragma unroll
        for (int ai = 0; ai < 2; ++ai)
#pragma unroll
            for (int m = 0; m < 4; ++m) { const int row = row0 + ai * HALF + m * 16; float s = 0.f;
#pragma unroll
                for (int bj = 0; bj < 2; ++bj) { const u32x4 r = rv[ai][m][bj];
                    const f32x4 r0 = {__uint_as_float(r.x << 16), __uint_as_float(r.x & 0xffff0000u), __uint_as_float(r.y << 16), __uint_as_float(r.y & 0xffff0000u)};
                    const f32x4 r1 = {__uint_as_float(r.z << 16), __uint_as_float(r.z & 0xffff0000u), __uint_as_float(r.w << 16), __uint_as_float(r.w & 0xffff0000u)};
                    const f32x4 o0 = r0 + acc[ai][bj][m][0] * alpha, o1 = r1 + acc[ai][bj][m][1] * alpha;
                    s += (o0[0] * o0[0] + o0[1] * o0[1]) + (o0[2] * o0[2] + o0[3] * o0[3]) + (o1[0] * o1[0] + o1[1] * o1[1]) + (o1[2] * o1[2] + o1[3] * o1[3]);
                    u32x4 w; w.x = cvt_pk_bf16(o0[0], o0[1]); w.y = cvt_pk_bf16(o0[2], o0[3]); w.z = cvt_pk_bf16(o1[0], o1[1]); w.w = cvt_pk_bf16(o1[2], o1[3]);
                    *(u32x4*)(xb + (size_t)row * D + col0 + bj * HALF) = w; }
                if (ss) { s = sum_fq(s); if (fq == 0) atomicAdd(ss + row, s); } }
        asm volatile("" ::: "memory");
    }
};
template <bool RES_BF16, bool OUT_F32, bool OUT_BF16> struct EpiRes {
    static constexpr bool PRE = false, PERM = false, FOLD = false, EPI_TWICE = false, EPI_DRY = false;
    static constexpr int TOUCH = 0;
    static constexpr int NB = RES_BF16 ? 1 : 2;
    const float* resf; const bf16_t* resb; float* out; bf16_t* xb; float* ss; float alpha;
    __device__ __forceinline__ void operator()(const f32x4 (&acc)[2][2][4][2], const Unit& u, int wr, int wc, int fr, int fq) const {
        const int row0 = u.pm * BM + wr * 64 + fr, col0 = u.pn * BM + wc * 32 + 4 * fq;
#pragma unroll
        for (int bt = 0; bt < NB; ++bt) {
            f32x4 rvf[RES_BF16 ? 1 : 1][RES_BF16 ? 1 : 4][2][2]; u32x2 rvb[RES_BF16 ? 2 : 1][RES_BF16 ? 4 : 1][2][2];
#pragma unroll
            for (int a2 = 0; a2 < 2 / NB; ++a2)
#pragma unroll
                for (int m = 0; m < 4; ++m) { const int ai = bt * (2 / NB) + a2; const size_t off = (size_t)(row0 + ai * HALF + m * 16) * D + col0;
#pragma unroll
                    for (int bj = 0; bj < 2; ++bj)
#pragma unroll
                        for (int n = 0; n < 2; ++n) { if (RES_BF16) rvb[a2][m][bj][n] = *(const u32x2*)(resb + off + bj * HALF + n * 16); else rvf[0][m][bj][n] = *(const f32x4*)(resf + off + bj * HALF + n * 16); } }
            asm volatile("" ::: "memory");
#pragma unroll
            for (int a2 = 0; a2 < 2 / NB; ++a2)
#pragma unroll
                for (int m = 0; m < 4; ++m) { const int ai = bt * (2 / NB) + a2, row = row0 + ai * HALF + m * 16; const size_t off = (size_t)row * D + col0; float s = 0.f;
#pragma unroll
                    for (int bj = 0; bj < 2; ++bj)
#pragma unroll
                        for (int n = 0; n < 2; ++n) {
                            f32x4 rv;
                            if (RES_BF16) { const u32x2 w = rvb[a2][m][bj][n]; rv = (f32x4){__uint_as_float(w.x << 16), __uint_as_float(w.x & 0xffff0000u), __uint_as_float(w.y << 16), __uint_as_float(w.y & 0xffff0000u)}; }
                            else rv = rvf[0][m][bj][n];
                            const f32x4 o = rv + acc[ai][bj][m][n] * alpha;
                            if (OUT_F32) *(f32x4*)(out + off + bj * HALF + n * 16) = o;
                            s += (o[0] * o[0] + o[1] * o[1]) + (o[2] * o[2] + o[3] * o[3]);
                            if (OUT_BF16) { u32x2 w; w.x = cvt_pk_bf16(o[0], o[1]); w.y = cvt_pk_bf16(o[2], o[3]); *(u32x2*)(xb + off + bj * HALF + n * 16) = w; } }
                    if (ss) { s = sum_fq(s); if (fq == 0) atomicAdd(ss + row, s); } }
            asm volatile("" ::: "memory"); }
    }
};
struct EpiWin {
    static constexpr bool PERM = true, FOLD = false, EPI_TWICE = false, EPI_DRY = false; static constexpr int TOUCH = 0;
    bf16_t* QKV; unsigned char* G; const float* ss1; const float *gq, *gk, *gxq; bf16_t* dry; bf16_t* drybase;
    static constexpr bool PRE = true;
    __device__ __forceinline__ RowPre pre(const Unit& u, int wr, int fr) const { RowPre q; const int row0 = u.pm * BM + wr * 64 + fr;
#pragma unroll
        for (int ai = 0; ai < 2; ++ai)
#pragma unroll
            for (int m = 0; m < 4; ++m) q.r[ai][m] = ss1[row0 + ai * HALF + m * 16];
        return q; }
    __device__ __forceinline__ void operator()(const f32x4 (&acc)[2][2][4][2], const Unit& u, int wr, int wc, int fr, int fq, const RowPre& q) const {
        const int row0 = u.pm * BM + wr * 64 + fr;
        if (u.pn >= 10) {
            const int col0 = (u.pn - 10) * BM + wc * 64 + 16 * fq;
#pragma unroll
            for (int ai = 0; ai < 2; ++ai)
#pragma unroll
                for (int m = 0; m < 4; ++m) { const int row = row0 + ai * HALF + m * 16; const float r = __builtin_amdgcn_rsqf(q.r[ai][m] * (1.0f / D) + EPS); u32x4 w;
                    w.x = gate_q4(acc[ai][0][m][0] * r); w.y = gate_q4(acc[ai][0][m][1] * r); w.z = gate_q4(acc[ai][1][m][0] * r); w.w = gate_q4(acc[ai][1][m][1] * r);
                    store16_wt((void*)(G + (size_t)row * NGATE + col0), w); }
            return;
        }
        const int head = 4 * u.pn + wc;
        const bool norm = (head >= 18 && head < 30) || head >= 36;
        const float* gain = (head >= 18 && head < 24) ? gq : (head >= 24 && head < 30) ? gk : (head >= 36) ? gxq : nullptr;
        const float cs = (head < 6 || (head >= 18 && head < 24) || head >= 36) ? QSCALE : 1.0f;
        f32x4 mul[2][2];
#pragma unroll
        for (int bj = 0; bj < 2; ++bj)
#pragma unroll
            for (int n = 0; n < 2; ++n) { f32x4 g = {1.f, 1.f, 1.f, 1.f}; if (gain) g = *(const f32x4*)(gain + 32 * bj + 8 * fq + 4 * n); mul[bj][n] = g * cs; }
#pragma unroll
        for (int ai = 0; ai < 2; ++ai)
#pragma unroll
            for (int m = 0; m < 4; ++m) { const int row = row0 + ai * HALF + m * 16; const float r = __builtin_amdgcn_rsqf(q.r[ai][m] * (1.0f / D) + EPS); f32x4 v[2][2]; float s = 0.f;
#pragma unroll
                for (int bj = 0; bj < 2; ++bj)
#pragma unroll
                    for (int n = 0; n < 2; ++n) { v[bj][n] = acc[ai][bj][m][n] * r; const f32x4 t = v[bj][n]; s += (t[0] * t[0] + t[1] * t[1]) + (t[2] * t[2] + t[3] * t[3]); }
                float hr = 1.0f;
                if (norm) { s = sum_fq(s); hr = __builtin_amdgcn_rsqf(s * (1.0f / HD) + EPS); }
#pragma unroll
                for (int bj = 0; bj < 2; ++bj) { const f32x4 v0 = v[bj][0] * mul[bj][0] * hr, v1 = v[bj][1] * mul[bj][1] * hr; u32x4 w;
                    w.x = cvt_pk_bf16(v0[0], v0[1]); w.y = cvt_pk_bf16(v0[2], v0[3]); w.z = cvt_pk_bf16(v1[0], v1[1]); w.w = cvt_pk_bf16(v1[2], v1[3]);
                    store16_wt((void*)(QKV + ((size_t)head * M + row) * 64 + bj * 32 + 8 * fq), w); } }
    }
};
template <int STEP> struct EpiBranch {
    static constexpr bool PRE = false, PERM = true, FOLD = false, EPI_TWICE = false, EPI_DRY = false; static constexpr int TOUCH = 0;
    static constexpr int NB = STEP > 0 ? 2 : 1;
    const unsigned char* G; bf16_t* macc; bf16_t* merged;
    static __device__ __forceinline__ void up8(f32x4& lo, f32x4& hi, u32x4 w) {
        lo = (f32x4){__uint_as_float(w.x << 16), __uint_as_float(w.x & 0xffff0000u), __uint_as_float(w.y << 16), __uint_as_float(w.y & 0xffff0000u)};
        hi = (f32x4){__uint_as_float(w.z << 16), __uint_as_float(w.z & 0xffff0000u), __uint_as_float(w.w << 16), __uint_as_float(w.w & 0xffff0000u)}; }
    __device__ __forceinline__ void operator()(const f32x4 (&acc)[2][2][4][2], const Unit& u, int wr, int wc, int fr, int fq) const {
        const int row0 = u.pm * BM + wr * 64 + fr, col0 = u.pn * BM + wc * 32 + 8 * fq;
#pragma unroll
        for (int bt = 0; bt < NB; ++bt) {
            u32x2 gw[2 / NB][4][2]; u32x4 mw[1][STEP > 0 ? 4 : 1][2];
#pragma unroll
            for (int a2 = 0; a2 < 2 / NB; ++a2)
#pragma unroll
                for (int m = 0; m < 4; ++m) { const int ai = bt * (2 / NB) + a2, row = row0 + ai * HALF + m * 16;
#pragma unroll
                    for (int bj = 0; bj < 2; ++bj) { const int col = col0 + bj * HALF; gw[a2][m][bj] = *(const u32x2*)(G + (size_t)row * NGATE + col + STEP * D);
                        if (STEP > 0) mw[0][m][bj] = *(const u32x4*)(macc + (size_t)row * D + col); } }
            asm volatile("" ::: "memory");
#pragma unroll
            for (int a2 = 0; a2 < 2 / NB; ++a2)
#pragma unroll
                for (int m = 0; m < 4; ++m) { const int ai = bt * (2 / NB) + a2, row = row0 + ai * HALF + m * 16;
#pragma unroll
                    for (int bj = 0; bj < 2; ++bj) { const int col = col0 + bj * HALF;
                        f32x4 g0 = gate_dq4(gw[a2][m][bj].x), g1 = gate_dq4(gw[a2][m][bj].y);
#pragma unroll
                        for (int i = 0; i < 4; ++i) { g0[i] = fast_sigmoid(g0[i]); g1[i] = fast_sigmoid(g1[i]); }
                        f32x4 v0 = g0 * acc[ai][bj][m][0], v1 = g1 * acc[ai][bj][m][1];
                        if (STEP > 0) { f32x4 m0, m1; up8(m0, m1, mw[0][m][bj]); v0 += m0; v1 += m1; }
                        u32x4 w; w.x = cvt_pk_bf16(v0[0], v0[1]); w.y = cvt_pk_bf16(v0[2], v0[3]); w.z = cvt_pk_bf16(v1[0], v1[1]); w.w = cvt_pk_bf16(v1[2], v1[3]);
                        *(u32x4*)((STEP < 2 ? macc : merged) + (size_t)row * D + col) = w; } }
            asm volatile("" ::: "memory"); }
    }
};

struct EpiBranchChain {
    static constexpr bool PRE = false, PERM = true, FOLD = false, EPI_TWICE = false, EPI_DRY = false; static constexpr int TOUCH = 0;
    const unsigned char* G; bf16_t* macc; bf16_t* merged;
    struct Q { u32x2 g[2][2]; u32x4 m[2][2]; };
    __device__ __forceinline__ void operator()(const f32x4 (&acc)[2][2][4][2], const Unit& u, int wr, int wc, int fr, int fq) const {
        const int row0 = u.pm * BM + wr * 64 + fr, col0 = u.pn * BM + wc * 32 + 8 * fq, step = u.step;
        const unsigned char* gb = G + step * D; bf16_t* dst = step < 2 ? macc : merged;
        auto load = [&](Q& s, const int q) __attribute__((always_inline)) {
#pragma unroll
            for (int mm = 0; mm < 2; ++mm) { const int row = row0 + (q >> 1) * HALF + (2 * (q & 1) + mm) * 16;
#pragma unroll
                for (int bj = 0; bj < 2; ++bj) { s.g[mm][bj] = *(const u32x2*)(gb + (size_t)row * NGATE + col0 + bj * HALF); s.m[mm][bj] = (u32x4){0u, 0u, 0u, 0u}; } }
            if (step > 0) {
#pragma unroll
                for (int mm = 0; mm < 2; ++mm)
#pragma unroll
                    for (int bj = 0; bj < 2; ++bj) s.m[mm][bj] = *(const u32x4*)(macc + (size_t)(row0 + (q >> 1) * HALF + (2 * (q & 1) + mm) * 16) * D + col0 + bj * HALF); }
        };
        auto work = [&](const Q& s, const int q) __attribute__((always_inline)) {
#pragma unroll
            for (int mm = 0; mm < 2; ++mm) { const int ai = q >> 1, m = 2 * (q & 1) + mm, row = row0 + ai * HALF + m * 16;
#pragma unroll
                for (int bj = 0; bj < 2; ++bj) { const int col = col0 + bj * HALF;
                    f32x4 g0 = gate_dq4(s.g[mm][bj].x), g1 = gate_dq4(s.g[mm][bj].y), m0, m1;
#pragma unroll
                    for (int i = 0; i < 4; ++i) { g0[i] = fast_sigmoid(g0[i]); g1[i] = fast_sigmoid(g1[i]); }
                    EpiBranch<1>::up8(m0, m1, s.m[mm][bj]);
                    const f32x4 v0 = g0 * acc[ai][bj][m][0] + m0, v1 = g1 * acc[ai][bj][m][1] + m1;
                    u32x4 w; w.x = cvt_pk_bf16(v0[0], v0[1]); w.y = cvt_pk_bf16(v0[2], v0[3]); w.z = cvt_pk_bf16(v1[0], v1[1]); w.w = cvt_pk_bf16(v1[2], v1[3]);
                    *(u32x4*)(dst + (size_t)row * D + col) = w; } }
        };
        Q sa, sb;
        load(sa, 0); load(sb, 1); asm volatile("" ::: "memory");
        work(sa, 0); asm volatile("" ::: "memory"); load(sa, 2); asm volatile("" ::: "memory");
        work(sb, 1); asm volatile("" ::: "memory"); load(sb, 3); asm volatile("" ::: "memory");
        work(sa, 2); asm volatile("" ::: "memory");
        work(sb, 3); asm volatile("" ::: "memory");
    }
};

template <class Epi, class Sched>
__device__ __forceinline__ void gemm_phase(PG8_LAS unsigned char* lds, const Gemm g, const Sched& S, const Epi& E, const int wid  ) {
    int lane; asm volatile("v_mbcnt_lo_u32_b32 %0, -1, 0\n\tv_mbcnt_hi_u32_b32 %0, -1, %0" : "=v"(lane));
    const int tid = wid * 64 + lane, wr = wid >> 2, wc = wid & 3, fr = lane & 15, fq = lane >> 4;
    const int ldb = g.ldb, lda = g.lda; int nt = g.K / BK;
    unsigned voffA[2], voffB[2];
#pragma unroll
    for (int i = 0; i < 2; ++i) { int R, C; stage_rc(tid * 16 + i * 8192, R, C); const int Rb = Epi::PERM ? ((R & ~31) + perm32(R & 31)) : R;
        voffA[i] = (unsigned)(R * lda + C) * 2u; voffB[i] = (unsigned)(Rb * ldb + C) * 2u; }
    const size_t kstep = (size_t)(BK * 2);
    const size_t hsA = (size_t)HALF * lda * 2, hsB = (size_t)HALF * ldb * 2;
    const size_t tsA = 2 * hsA, tsB = 2 * hsB;
    const unsigned ldsw = (unsigned)wid * 1024u;
    const int aoff = lds_byte(wr * 64 + fr, fq * 8), boff = lds_byte(wc * 32 + fr, fq * 8);
#define PG8_SA(b, h) (((b) * 2 + (h)) * HTB)
#define PG8_SB(b, h) ((4 + (b) * 2 + (h)) * HTB)
#define PG8_STAGE(bufoff, gbase, voff) do { _Pragma("unroll") for (int _i = 0; _i < 2; ++_i) \
        __builtin_amdgcn_global_load_lds((const unsigned*)((const char*)(gbase) + (voff)[_i]), (PG8_LAS unsigned*)(lds + (bufoff) + ldsw + _i * 8192), 16, 0, 0); } while (0)
    PG8_LAS const unsigned char* ldsA = lds + aoff; PG8_LAS const unsigned char* ldsB = lds + 4 * HTB + boff;
    asm volatile("" : "+v"(ldsA), "+v"(ldsB));
#define PG8_LDA(dst, b, h) do { _Pragma("unroll") for (int m = 0; m < 4; ++m) _Pragma("unroll") for (int k = 0; k < 2; ++k) dst[m][k] = *(const PG8_LAS bf16x8*)(ldsA + ((b) * 2 + (h)) * HTB + m * 2048 + k * 1024); } while (0)
#define PG8_LDB(dst, b, h) do { _Pragma("unroll") for (int n = 0; n < 2; ++n) _Pragma("unroll") for (int k = 0; k < 2; ++k) dst[n][k] = *(const PG8_LAS bf16x8*)(ldsB + ((b) * 2 + (h)) * HTB + n * 2048 + k * 1024); } while (0)
#define PG8_MMA(ai, bj, At, Bt) do { __builtin_amdgcn_s_setprio(1); _Pragma("unroll") for (int m = 0; m < 4; ++m) _Pragma("unroll") for (int n = 0; n < 2; ++n) _Pragma("unroll") for (int k = 0; k < 2; ++k) \
        acc[ai][bj][m][n] = __builtin_amdgcn_mfma_f32_16x16x32_bf16(Bt[n][k], At[m][k], acc[ai][bj][m][n], 0, 0, 0); __builtin_amdgcn_s_setprio(0); } while (0)
#define PG8_WAIT_V(n) asm volatile("s_waitcnt vmcnt(" #n ")" ::: "memory")
#define PG8_WAIT_L(n) asm volatile("s_waitcnt lgkmcnt(" #n ")" ::: "memory")
#define PG8_BAR __builtin_amdgcn_s_barrier()
#define PG8_SCHED __builtin_amdgcn_sched_barrier(0)
#if !PG8_USE_SP2
#define PG8_KTILE2(t) do { \
            const bool last = (t == nt - 2); \
            const char* a1 = cA + (size_t)(t + 1) * kstep; \
            const char* a2 = last ? nA : cA + (size_t)(t + 2) * kstep; const char* b2 = last ? nB : cB + (size_t)(t + 2) * kstep; \
            const char* a3 = a2 + kstep; const char* b3 = b2 + kstep; \
            PG8_LDB(B0, 0, 0); PG8_SCHED; PG8_LDA(At, 0, 0); PG8_STAGE(PG8_SA(1, 1), a1 + hsA, voffA); \
            PG8_WAIT_L(8); PG8_BAR; PG8_WAIT_L(0); PG8_MMA(0, 0, At, B0); PG8_BAR; PG8_SCHED; \
            PG8_LDB(B1, 0, 1); PG8_STAGE(PG8_SB(0, 0), b2, voffB); \
            PG8_BAR; PG8_WAIT_L(0); PG8_MMA(0, 1, At, B1); PG8_BAR; \
            PG8_LDA(At, 0, 1); PG8_STAGE(PG8_SA(0, 0), a2, voffA); \
            PG8_BAR; PG8_WAIT_L(0); PG8_MMA(1, 0, At, B0); PG8_BAR; PG8_SCHED; \
            PG8_STAGE(PG8_SB(0, 1), b2 + hsB, voffB); \
            PG8_WAIT_V(6); PG8_BAR; PG8_MMA(1, 1, At, B1); PG8_BAR; \
            PG8_LDB(B0, 1, 0); PG8_SCHED; PG8_LDA(At, 1, 0); PG8_STAGE(PG8_SA(0, 1), a2 + hsA, voffA); \
            PG8_WAIT_L(8); PG8_BAR; PG8_WAIT_L(0); PG8_MMA(0, 0, At, B0); PG8_BAR; PG8_SCHED; \
            PG8_LDB(B1, 1, 1); PG8_STAGE(PG8_SB(1, 0), b3, voffB); \
            PG8_BAR; PG8_WAIT_L(0); PG8_MMA(0, 1, At, B1); PG8_BAR; \
            PG8_LDA(At, 1, 1); PG8_STAGE(PG8_SA(1, 0), a3, voffA); \
            PG8_BAR; PG8_WAIT_L(0); PG8_MMA(1, 0, At, B0); PG8_BAR; PG8_SCHED; \
            PG8_STAGE(PG8_SB(1, 1), b3 + hsB, voffB); \
            PG8_WAIT_V(6); PG8_BAR; PG8_MMA(1, 1, At, B1); PG8_BAR; \
        } while (0)
#else
#define PG8_KTILE2(t) do { \
            const bool last = (t == nt - 2); \
            const char* a1 = cA + (size_t)(t + 1) * kstep; \
            const char* a2 = last ? nA : cA + (size_t)(t + 2) * kstep; const char* b2 = last ? nB : cB + (size_t)(t + 2) * kstep; \
            const char* a3 = a2 + kstep; const char* b3 = b2 + kstep; \
            PG8_LDB(B0, 0, 0); PG8_LDB(B1, 0, 1); PG8_SCHED; PG8_LDA(At, 0, 0); PG8_STAGE(PG8_SA(1, 1), a1 + hsA, voffA); \
            PG8_WAIT_V(8); PG8_WAIT_L(0); PG8_BAR; PG8_MMA(0, 0, At, B0); PG8_MMA(0, 1, At, B1); PG8_BAR; PG8_SCHED; \
            PG8_LDA(At, 0, 1); PG8_STAGE(PG8_SB(0, 0), b2, voffB); PG8_STAGE(PG8_SB(0, 1), b2 + hsB, voffB); PG8_STAGE(PG8_SA(0, 0), a2, voffA); \
            PG8_WAIT_V(8); PG8_WAIT_L(0); PG8_BAR; PG8_MMA(1, 0, At, B0); PG8_MMA(1, 1, At, B1); PG8_BAR; PG8_SCHED; \
            PG8_LDB(B0, 1, 0); PG8_LDB(B1, 1, 1); PG8_SCHED; PG8_LDA(At, 1, 0); PG8_STAGE(PG8_SA(0, 1), a2 + hsA, voffA); \
            PG8_WAIT_V(8); PG8_WAIT_L(0); PG8_BAR; PG8_MMA(0, 0, At, B0); PG8_MMA(0, 1, At, B1); PG8_BAR; PG8_SCHED; \
            PG8_LDA(At, 1, 1); PG8_STAGE(PG8_SB(1, 0), b3, voffB); PG8_STAGE(PG8_SB(1, 1), b3 + hsB, voffB); PG8_STAGE(PG8_SA(1, 0), a3, voffA); \
            PG8_WAIT_V(8); PG8_WAIT_L(0); PG8_BAR; PG8_MMA(1, 0, At, B0); PG8_MMA(1, 1, At, B1); PG8_BAR; PG8_SCHED; \
        } while (0)
#endif
    Unit cur, nxt; int ui = 0;
    if (!S.next(0, cur)) return;
    f32x4 acc[2][2][4][2];
#pragma unroll
    for (int a = 0; a < 2; ++a)
#pragma unroll
        for (int b = 0; b < 2; ++b)
#pragma unroll
            for (int m = 0; m < 4; ++m)
#pragma unroll
                for (int n = 0; n < 2; ++n) acc[a][b][m][n] = (f32x4){0.f, 0.f, 0.f, 0.f};
    bf16x8 At[4][2], B0[2][2], B1[2][2];
    const char* cA = (const char*)g.A + (size_t)cur.pm * tsA + (size_t)cur.koff * 2; const char* cB = (const char*)g.Bt + (size_t)cur.pn * tsB + (size_t)cur.koff * 2;
    if (cur.ntu) nt = cur.ntu;
#if PG8_USE_SP2
    PG8_STAGE(PG8_SB(0, 0), cB, voffB); PG8_STAGE(PG8_SB(0, 1), cB + hsB, voffB); PG8_STAGE(PG8_SA(0, 0), cA, voffA); PG8_STAGE(PG8_SA(0, 1), cA + hsA, voffA);
    if (wr == 1) PG8_BAR;
    PG8_WAIT_V(2); PG8_BAR;
#else
    PG8_STAGE(PG8_SB(0, 0), cB, voffB); PG8_STAGE(PG8_SA(0, 0), cA, voffA); PG8_STAGE(PG8_SB(0, 1), cB + hsB, voffB); PG8_STAGE(PG8_SA(0, 1), cA + hsA, voffA);
    if (wr == 1) PG8_BAR;
    PG8_WAIT_V(4); PG8_BAR;
#endif
    PG8_STAGE(PG8_SB(1, 0), cB + kstep, voffB); PG8_STAGE(PG8_SA(1, 0), cA + kstep, voffA); PG8_STAGE(PG8_SB(1, 1), cB + hsB + kstep, voffB);
    PG8_WAIT_V(6); PG8_BAR;
    for (;;) {
        RowPre rowpre; if constexpr (Epi::PRE) rowpre = E.pre(cur, wr, fr);
        const bool has_next = S.next(ui + 1, nxt);
        const char* nA = has_next ? (const char*)g.A + (size_t)nxt.pm * tsA + (size_t)nxt.koff * 2 : cA; const char* nB = has_next ? (const char*)g.Bt + (size_t)nxt.pn * tsB + (size_t)nxt.koff * 2 : cB;
        if constexpr (Epi::FOLD) {
            static_assert(Epi::NT == 12 && Epi::F1 == 6 && Epi::F2 == 8, "the fold walk below is written out for K = 384 | 128 | 256");
            PG8_KTILE2(0); PG8_KTILE2(2); PG8_KTILE2(4);
            PG8_SCHED; E.fold(acc, cur, 0, wr, wc, fr, fq); PG8_SCHED;
            PG8_KTILE2(6);
            PG8_SCHED; E.fold(acc, cur, 1, wr, wc, fr, fq); PG8_SCHED;
            PG8_KTILE2(8); PG8_KTILE2(10);
        } else {
            for (int t = 0; t < nt; t += 2) { if constexpr (Epi::TOUCH > 0) { if (t < 2 * Epi::TOUCH) E.touch(cur, t >> 1, wid, lane, lds); } PG8_KTILE2(t); }
        }
        if (wr == 0) PG8_BAR;
        if constexpr (Epi::PRE) E(acc, cur, wr, wc, fr, fq, rowpre); else E(acc, cur, wr, wc, fr, fq);
        if (!has_next) break;
#pragma unroll
        for (int a = 0; a < 2; ++a)
#pragma unroll
            for (int b = 0; b < 2; ++b)
#pragma unroll
                for (int m = 0; m < 4; ++m)
#pragma unroll
                    for (int n = 0; n < 2; ++n) acc[a][b][m][n] = (f32x4){0.f, 0.f, 0.f, 0.f};
        cur = nxt; cA = nA; cB = nB; ++ui; if (cur.ntu) nt = cur.ntu;
        if (wr == 1) PG8_BAR;
    }
    PG8_WAIT_V(0);
    PG8_BAR;
#undef PG8_SA
#undef PG8_SB
#undef PG8_STAGE
#undef PG8_LDA
#undef PG8_LDB
#undef PG8_MMA
#undef PG8_WAIT_V
#undef PG8_WAIT_L
#undef PG8_BAR
#undef PG8_SCHED
#undef PG8_KTILE2
}
}

namespace att {
#define ATT_LAS __attribute__((address_space(3)))
typedef short bf16x8 __attribute__((ext_vector_type(8)));
typedef short s16x4 __attribute__((ext_vector_type(4)));
typedef float f32x16 __attribute__((ext_vector_type(16)));
typedef unsigned u32x2 __attribute__((ext_vector_type(2)));
typedef unsigned u32x4 __attribute__((ext_vector_type(4)));
constexpr int KSTRIDE = 144, KSTAGE = 32 * KSTRIDE;
constexpr int VSTRIDE = 192, VSTAGE = 32 * VSTRIDE;
constexpr int WSTAGE = KSTAGE + VSTAGE;
constexpr int TBLN = 132;
constexpr int LDS_TBL = 0, LDS_VST = 4096, LDS_BYTES = LDS_VST + 8 * WSTAGE;
constexpr float NEG = -1e30f;
__device__ __forceinline__ int crow(int r, int hi) { return (r & 3) + 8 * (r >> 2) + 4 * hi; }
typedef float f32x2_t __attribute__((ext_vector_type(2))); typedef __bf16 bf16x2_t __attribute__((ext_vector_type(2)));
__device__ __forceinline__ unsigned cvtpk(float lo, float hi) { const f32x2_t v = {lo, hi}; return __builtin_bit_cast(unsigned, __builtin_convertvector(v, bf16x2_t)); }

__device__ __forceinline__ void load_frag4(bf16x8 (&f)[4], const bf16_t* rowp, int hi) {
#pragma unroll
    for (int d0 = 0; d0 < 4; ++d0) f[d0] = *(const bf16x8*)(rowp + d0 * 16 + hi * 8);
}
__device__ __forceinline__ f32x16 qk_tile(const bf16x8 (&kf)[4], const bf16x8 (&qf)[4]) {
    f32x16 s = {0.f, 0.f, 0.f, 0.f, 0.f, 0.f, 0.f, 0.f, 0.f, 0.f, 0.f, 0.f, 0.f, 0.f, 0.f, 0.f};
#pragma unroll
    for (int d0 = 0; d0 < 4; ++d0) s = __builtin_amdgcn_mfma_f32_32x32x16_bf16(kf[d0], qf[d0], s, 0, 0, 0);
    return s;
}
struct TileRegs { u32x4 k[4], v[4]; };
template <class KRow, class VRow> __device__ __forceinline__ void load_tile(TileRegs& t, KRow krow, VRow vrow, int lane) {
#pragma unroll
    for (int j = 0; j < 4; ++j) { const int r = 8 * j + (lane >> 3); t.k[j] = *(const u32x4*)(krow(r) + (lane & 7) * 8); t.v[j] = *(const u32x4*)(vrow(r) + (lane & 7) * 8); }
}
__device__ __forceinline__ void stage_tile(ATT_LAS unsigned char* st, const TileRegs& t, int lane) {
#pragma unroll
    for (int j = 0; j < 4; ++j) { const int r = 8 * j + (lane >> 3);
        *(ATT_LAS u32x4*)(st + r * KSTRIDE + (lane & 7) * 16) = t.k[j]; *(ATT_LAS u32x4*)(st + KSTAGE + r * VSTRIDE + (lane & 7) * 16) = t.v[j]; }
}
__device__ __forceinline__ void read_kfrag(bf16x8 (&kf)[4], ATT_LAS const unsigned char* st, int lane) {
    ATT_LAS const unsigned char* p = st + (lane & 31) * KSTRIDE + (lane >> 5) * 16;
#pragma unroll
    for (int d0 = 0; d0 < 4; ++d0) kf[d0] = *(ATT_LAS const bf16x8*)(p + d0 * 32);
}
typedef short v4i16_t __attribute__((ext_vector_type(4)));
__device__ __forceinline__ s16x4 vtr(ATT_LAS const unsigned char* p) { return __builtin_bit_cast(s16x4, __builtin_amdgcn_ds_read_tr16_b64_v4i16((ATT_LAS v4i16_t*)p)); }
__device__ __forceinline__ void read_vfrag(bf16x8 (&vf)[2][2], ATT_LAS const unsigned char* vb) {
#pragma unroll
    for (int s = 0; s < 2; ++s)
#pragma unroll
        for (int d0 = 0; d0 < 2; ++d0) { const s16x4 lo = vtr(vb + (16 * s) * VSTRIDE + 64 * d0), hi = vtr(vb + (16 * s + 8) * VSTRIDE + 64 * d0);
            vf[s][d0] = (bf16x8){lo[0], lo[1], lo[2], lo[3], hi[0], hi[1], hi[2], hi[3]}; }
}
__device__ __forceinline__ void pv_mma(f32x16 (&o)[2], const bf16x8 (&vf)[2][2], const bf16x8 (&pw)[2]) {
#pragma unroll
    for (int s = 0; s < 2; ++s)
#pragma unroll
        for (int d0 = 0; d0 < 2; ++d0) o[d0] = __builtin_amdgcn_mfma_f32_32x32x16_bf16(vf[s][d0], pw[s], o[d0], 0, 0, 0);
}
__device__ __forceinline__ float swap32(float x) { const auto rr = __builtin_amdgcn_permlane32_swap(__float_as_uint(x), __float_as_uint(x), false, false); return __uint_as_float((__builtin_amdgcn_mbcnt_hi(~0u, __builtin_amdgcn_mbcnt_lo(~0u, 0u)) < 32u) ? rr[1] : rr[0]); }
__device__ __forceinline__ void pack_p(bf16x8 (&pw)[2], const f32x16& p) {
#pragma unroll
    for (int s = 0; s < 2; ++s) { u32x4 w; w.x = cvtpk(p[8 * s], p[8 * s + 1]); w.y = cvtpk(p[8 * s + 2], p[8 * s + 3]); w.z = cvtpk(p[8 * s + 4], p[8 * s + 5]); w.w = cvtpk(p[8 * s + 6], p[8 * s + 7]);
        pw[s] = __builtin_bit_cast(bf16x8, w); }
}
__device__ __forceinline__ void softmax_step(f32x16& p, float& m, float& zl, f32x16 (&o)[2]) {
    float tm = fmaxf(fmaxf(p[0], p[1]), fmaxf(p[2], p[3]));
#pragma unroll
    for (int r = 4; r < 16; r += 4) tm = fmaxf(tm, fmaxf(fmaxf(p[r], p[r + 1]), fmaxf(p[r + 2], p[r + 3])));
    { const auto rr = __builtin_amdgcn_permlane32_swap(__float_as_uint(tm), __float_as_uint(tm), false, false); tm = fmaxf(__uint_as_float(rr[0]), __uint_as_float(rr[1])); }
    if (__any(tm > m + 8.0f)) {
        const float mn = fmaxf(m, tm), al = __builtin_amdgcn_exp2f(m - mn); m = mn;
        zl *= al;
#pragma unroll
        for (int d0 = 0; d0 < 2; ++d0)
#pragma unroll
            for (int r = 0; r < 16; ++r) o[d0][r] *= al;
    }
    float s = 0.f;
#pragma unroll
    for (int r = 0; r < 16; ++r) { p[r] = __builtin_amdgcn_exp2f(p[r] - m); s += p[r]; }
    zl += s;
}
__device__ __forceinline__ void store_o(const f32x16 (&o)[2], float scale, bf16_t* orow, int hi) {
#pragma unroll
    for (int d0 = 0; d0 < 2; ++d0)
#pragma unroll
        for (int g = 0; g < 4; ++g) { u32x2 w; w.x = cvtpk(o[d0][4 * g] * scale, o[d0][4 * g + 1] * scale); w.y = cvtpk(o[d0][4 * g + 2] * scale, o[d0][4 * g + 3] * scale);
            *(u32x2*)(orow + 32 * d0 + 8 * g + 4 * hi) = w; }
}

template <bool DRY = false> __device__ __forceinline__ void sb_unit(int id, const bf16_t* QKV, bf16_t* OC, ATT_LAS unsigned char* vst, int lane) {
    asm volatile("" : "+v"(lane));
    const int bh = id >> 8, qt = id & 255, b = bh / 6, h = bh - 6 * b, t0 = qt * 32, i = lane & 31, hi = lane >> 5;
    const size_t HS = (size_t)M * 64;
    const bf16_t* base = QKV + (size_t)h * HS + (size_t)b * S * 64;
    bf16x8 qf[4]; load_frag4(qf, base + (size_t)(t0 + i) * 64, hi);
    f32x16 o[2];
#pragma unroll
    for (int r = 0; r < 16; ++r) { o[0][r] = 0.f; o[1][r] = 0.f; }
    ATT_LAS const unsigned char* vb = vst + KSTAGE + (4 * hi + ((lane & 15) >> 2)) * VSTRIDE + ((lane >> 4) & 1) * 32 + (lane & 3) * 8;
    float c = 0.f;
#define SB_LOAD(T_, k_) load_tile(T_, [&](int r) { return base + 6 * HS + (size_t)((k_) + r) * 64; }, [&](int r) { return base + 12 * HS + (size_t)((k_) + r) * 64; }, lane)
    auto tile = [&](const int k0, TileRegs& tr, const int knext) __attribute__((always_inline)) -> bool {
        asm volatile("s_waitcnt lgkmcnt(0)" ::: "memory");
        stage_tile(vst, tr, lane);
        if (knext >= 0 && !DRY) SB_LOAD(tr, knext);
        asm volatile("s_waitcnt lgkmcnt(0)" ::: "memory");
        bf16x8 kf[4], vf[2][2]; read_kfrag(kf, vst, lane); read_vfrag(vf, vb);
        f32x16 z = qk_tile(kf, qf);
        float w[16];
        const bool diag = (k0 == t0);
#pragma unroll
        for (int r = 0; r < 16; ++r) { const float zz = z[r], e = __builtin_amdgcn_exp2f(-fabsf(zz)), l2 = __builtin_amdgcn_logf(1.0f + e);
            w[r] = fmaxf(zz, 0.f) + l2; z[r] = fminf(zz, 0.f) - l2; }
        if (diag) { int ii = i - 4 * hi; asm volatile("" : "+v"(ii));
#pragma unroll
            for (int r = 0; r < 16; ++r) if (!((r & 3) + 8 * (r >> 2) < ii)) { w[r] = 0.f; z[r] = NEG; } }
        float a[16], T[4], Tp[4];
#pragma unroll
        for (int g = 0; g < 4; ++g) { a[4 * g + 3] = 0.f; a[4 * g + 2] = w[4 * g + 3]; a[4 * g + 1] = a[4 * g + 2] + w[4 * g + 2]; a[4 * g] = a[4 * g + 1] + w[4 * g + 1]; T[g] = a[4 * g] + w[4 * g]; }
#pragma unroll
        for (int g = 0; g < 4; ++g) { const auto rr = __builtin_amdgcn_permlane32_swap(__float_as_uint(T[g]), __float_as_uint(T[g]), false, false); Tp[g] = __uint_as_float(hi == 0 ? rr[1] : rr[0]); }
        const float p3 = T[3] + Tp[3], p2 = T[2] + Tp[2], p1 = T[1] + Tp[1], p0 = T[0] + Tp[0];
        float cum[4]; cum[3] = 0.f; cum[2] = p3; cum[1] = p3 + p2; cum[0] = cum[1] + p1; const float total = cum[0] + p0;
        f32x16 p;
#pragma unroll
        for (int g = 0; g < 4; ++g) { const float bg = c - cum[g] - (hi == 0 ? Tp[g] : 0.f);
#pragma unroll
            for (int j = 0; j < 4; ++j) p[4 * g + j] = __builtin_amdgcn_exp2f(z[4 * g + j] + (bg - a[4 * g + j])); }
        c -= total;
        bf16x8 pw[2]; pack_p(pw, p);
        pv_mma(o, vf, pw);
        return k0 < 32 || __all(c < -150.0f);
    };
    TileRegs ta, tb;
    SB_LOAD(ta, t0); if (t0 >= 32) SB_LOAD(tb, t0 - 32);
#pragma unroll 1
    for (int k0 = t0; ; k0 -= 64) {
        if (tile(k0, ta, k0 - 64)) break;
        if (tile(k0 - 32, tb, k0 - 96)) break;
    }
#undef SB_LOAD
    store_o(o, 1.0f, OC + (size_t)(DRY ? ((b * S + t0 + i) & 4095) : (b * S + t0 + i)) * NOC + h * 64, hi);
}

__device__ __forceinline__ void dil_tile(int T, int& g, int& kt) { if (T < 5) { g = 2; kt = T; } else if (T < 13) { g = 1; kt = T - 5; } else { g = 0; kt = T - 13; } }
template <bool DRY = false> __device__ __forceinline__ void dil_unit(int id, const bf16_t* QKV, bf16_t* OC, ATT_LAS const float* tbl, ATT_LAS unsigned char* vst, int lane) {
    asm volatile("" : "+v"(lane));
    const int b = id >> 9, hh = (id >> 8) & 1, blk = (id >> 4) & 15, res = id & 15, i = lane & 31, hi = lane >> 5;
    const int tb = 512 * blk + res, tq = tb + 16 * i;
    const size_t HS = (size_t)M * 64;
    const bf16_t* base = QKV + (size_t)b * S * 64;
    f32x16 o[2];
#pragma unroll
    for (int r = 0; r < 16; ++r) { o[0][r] = 0.f; o[1][r] = 0.f; }
    ATT_LAS const unsigned char* vb = vst + KSTAGE + (4 * hi + ((lane & 15) >> 2)) * VSTRIDE + ((lane >> 4) & 1) * 32 + (lane & 3) * 8;
    float m = NEG, zl = 0.f;
    bf16x8 qf[4];
#define DIL_LOAD(R_, T_) do { int g_, kt_; dil_tile((T_), g_, kt_); const int sh_ = 2 * g_, hd_ = 2 * g_ + hh, rg_ = tb & ((1 << sh_) - 1), Jt_ = (tb >> sh_) - 128 + 32 * kt_, Jm_ = (S >> sh_) - 1; \
        auto krow_ = [&](int r) { int J_ = Jt_ + r; J_ = J_ < 0 ? 0 : J_; J_ = J_ > Jm_ ? Jm_ : J_; return base + (size_t)(24 + hd_) * HS + (size_t)(rg_ + (J_ << sh_)) * 64; }; \
        load_tile(R_, krow_, [&](int r) { return krow_(r) + 6 * HS; }, lane); } while (0)
    int gprev = -1;
    auto tile = [&](const int T, TileRegs& tr) __attribute__((always_inline)) {
        int g, kt; dil_tile(T, g, kt);
        const int sh = 2 * g, sq = 16 >> sh, Jt0 = (tb >> sh) - 128 + 32 * kt;
        if (g != gprev) { load_frag4(qf, base + (size_t)(18 + 2 * g + hh) * HS + (size_t)tq * 64, hi); gprev = g; }
        const bool skip = Jt0 + 31 < 0;
        asm volatile("s_waitcnt lgkmcnt(0)" ::: "memory");
        if (!skip) stage_tile(vst, tr, lane);
        if (T + 2 < 33 && !DRY) DIL_LOAD(tr, T + 2);
        if (skip) return;
        ATT_LAS const float* tb_g = tbl + (g * 2 + hh) * TBLN + 1;
        asm volatile("s_waitcnt lgkmcnt(0)" ::: "memory");
        bf16x8 kf[4], vf[2][2]; read_kfrag(kf, vst, lane); read_vfrag(vf, vb);
        f32x16 p = qk_tile(kf, qf);
        const int tb0 = (int)(unsigned)(unsigned long long)(ATT_LAS const unsigned char*)tb_g, c4 = tb0 + 4 * (sq * i + 128 - 32 * kt - 4 * hi), lo4 = tb0 - 4, hi4 = tb0 + 4 * 129;
        float bvs[16];
#pragma unroll
        for (int r = 0; r < 16; ++r) { int a4 = c4 - 4 * ((r & 3) + 8 * (r >> 2)); a4 = a4 < lo4 ? lo4 : a4; a4 = a4 > hi4 ? hi4 : a4; bvs[r] = *(ATT_LAS const float*)(ATT_LAS const unsigned char*)(unsigned long long)(unsigned)a4; }
        if (Jt0 < 0) {
#pragma unroll
            for (int r = 0; r < 16; ++r) if (Jt0 + 4 * hi + (r & 3) + 8 * (r >> 2) < 0) bvs[r] = NEG; }
#pragma unroll
        for (int r = 0; r < 16; ++r) p[r] += bvs[r];
        softmax_step(p, m, zl, o);
        bf16x8 pw[2]; pack_p(pw, p);
        pv_mma(o, vf, pw);
    };
    TileRegs ta, tbq;
    DIL_LOAD(ta, 0); DIL_LOAD(tbq, 1);
#pragma unroll 1
    for (int T = 0; T < 33; T += 2) {
        tile(T, ta);
        if (T + 1 < 33) tile(T + 1, tbq);
    }
#undef DIL_LOAD
    float Z; { const auto rr = __builtin_amdgcn_permlane32_swap(__float_as_uint(zl), __float_as_uint(zl), false, false); Z = __uint_as_float(rr[0]) + __uint_as_float(rr[1]); }
    store_o(o, 1.0f / Z, OC + (size_t)(DRY ? ((b * S + tq) & 4095) : (b * S + tq)) * NOC + 384 + hh * 64, hi);
}

__device__ __forceinline__ void dilg_unit(int b, int hh, int g, int r, int jt, const bf16_t* QKV, bf16_t* PART, float* LSE, ATT_LAS const float* tbl, ATT_LAS unsigned char* vst, int lane) {
    asm volatile("" : "+v"(lane));
    const int i = lane & 31, hi = lane >> 5, sh = 2 * g, J0 = 32 * jt, Jm = (S >> sh) - 1;
    const size_t HS = (size_t)M * 64;
    const bf16_t* kbase = QKV + (size_t)(24 + 2 * g + hh) * HS + (size_t)b * S * 64;
    const int tq = r + ((J0 + i) << sh);
    bf16x8 qf[4]; load_frag4(qf, kbase - 6 * HS + (size_t)tq * 64, hi);
    f32x16 o[2];
#pragma unroll
    for (int q = 0; q < 16; ++q) { o[0][q] = 0.f; o[1][q] = 0.f; }
    ATT_LAS const unsigned char* vb = vst + KSTAGE + (4 * hi + ((lane & 15) >> 2)) * VSTRIDE + ((lane >> 4) & 1) * 32 + (lane & 3) * 8;
    ATT_LAS const float* tb_g = tbl + (g * 2 + hh) * TBLN + 1;
    const int tb0 = (int)(unsigned)(unsigned long long)(ATT_LAS const unsigned char*)tb_g, lo4 = tb0 - 4, hi4 = tb0 + 4 * 129;
    float m = NEG, zl = 0.f;
#define DG_LOAD(R_, kt_) do { const int Jt_ = J0 - 128 + 32 * (kt_); \
        auto krow_ = [&](int q) { int J_ = Jt_ + q; J_ = J_ < 0 ? 0 : J_; J_ = J_ > Jm ? Jm : J_; return kbase + (size_t)(r + (J_ << sh)) * 64; }; \
        load_tile(R_, krow_, [&](int q) { return krow_(q) + 6 * HS; }, lane); } while (0)
    auto tile = [&](const int kt, TileRegs& tr) __attribute__((always_inline)) {
        const int Jt0 = J0 - 128 + 32 * kt;
        const bool skip = Jt0 + 31 < 0;
        asm volatile("s_waitcnt lgkmcnt(0)" ::: "memory");
        if (!skip) stage_tile(vst, tr, lane);
        if (kt + 2 < 5) DG_LOAD(tr, kt + 2);
        if (skip) return;
        asm volatile("s_waitcnt lgkmcnt(0)" ::: "memory");
        bf16x8 kf[4], vf[2][2]; read_kfrag(kf, vst, lane); read_vfrag(vf, vb);
        f32x16 p = qk_tile(kf, qf);
        const int c4 = tb0 + 4 * (i + 128 - 32 * kt - 4 * hi);
        float bvs[16];
#pragma unroll
        for (int q = 0; q < 16; ++q) { int a4 = c4 - 4 * ((q & 3) + 8 * (q >> 2)); a4 = a4 < lo4 ? lo4 : a4; a4 = a4 > hi4 ? hi4 : a4; bvs[q] = *(ATT_LAS const float*)(ATT_LAS const unsigned char*)(unsigned long long)(unsigned)a4; }
        if (Jt0 < 0) {
#pragma unroll
            for (int q = 0; q < 16; ++q) if (Jt0 + 4 * hi + (q & 3) + 8 * (q >> 2) < 0) bvs[q] = NEG; }
#pragma unroll
        for (int q = 0; q < 16; ++q) p[q] += bvs[q];
        softmax_step(p, m, zl, o);
        bf16x8 pw[2]; pack_p(pw, p);
        pv_mma(o, vf, pw);
    };
    TileRegs ta, tbq;
    DG_LOAD(ta, 0); DG_LOAD(tbq, 1);
    tile(0, ta); tile(1, tbq); tile(2, ta); tile(3, tbq); tile(4, ta);
#undef DG_LOAD
    float Z; { const auto rr = __builtin_amdgcn_permlane32_swap(__float_as_uint(zl), __float_as_uint(zl), false, false); Z = __uint_as_float(rr[0]) + __uint_as_float(rr[1]); }
    const size_t row = (size_t)b * S + tq;
    store_o(o, 1.0f / Z, PART + ((size_t)g * M + row) * 128 + hh * 64, hi);
    if (hi == 0) LSE[((size_t)g * M + row) * 2 + hh] = m + __builtin_amdgcn_logf(Z);
}
__device__ __forceinline__ void dil_combine(int b, int hh, int t0, int ntok, const bf16_t* PART, const float* LSE, bf16_t* OC, int lane) {
#pragma unroll 2
    for (int k = 0; k < ntok; k += 8) { const size_t row = (size_t)b * S + t0 + k + (lane >> 3);
        float l[3]; u32x4 pv[3];
#pragma unroll
        for (int g = 0; g < 3; ++g) { l[g] = LSE[((size_t)g * M + row) * 2 + hh]; pv[g] = *(const u32x4*)(PART + ((size_t)g * M + row) * 128 + hh * 64 + (lane & 7) * 8); }
        const float mx = fmaxf(fmaxf(l[0], l[1]), l[2]); float w[3], ws = 0.f;
#pragma unroll
        for (int g = 0; g < 3; ++g) { w[g] = __builtin_amdgcn_exp2f(l[g] - mx); ws += w[g]; }
        const float rz = __builtin_amdgcn_rcpf(ws); float acc[8];
#pragma unroll
        for (int e = 0; e < 8; ++e) acc[e] = 0.f;
#pragma unroll
        for (int g = 0; g < 3; ++g) { const float wg = w[g] * rz; const unsigned d4[4] = {pv[g].x, pv[g].y, pv[g].z, pv[g].w};
#pragma unroll
            for (int e = 0; e < 4; ++e) { acc[2 * e] += wg * __uint_as_float(d4[e] << 16); acc[2 * e + 1] += wg * __uint_as_float(d4[e] & 0xffff0000u); } }
        u32x4 o; o.x = cvtpk(acc[0], acc[1]); o.y = cvtpk(acc[2], acc[3]); o.z = cvtpk(acc[4], acc[5]); o.w = cvtpk(acc[6], acc[7]);
        *(u32x4*)(OC + row * NOC + 384 + hh * 64 + (lane & 7) * 8) = o; }
}

__device__ __forceinline__ void mem_unit(int id, const bf16_t* QKV, const bf16_t* MK, const bf16_t* MV, bf16_t* OC, ATT_LAS unsigned char* vst, int lane) {
    asm volatile("" : "+v"(lane));
    const int b = id >> 10, head = (id >> 8) & 3, qt = id & 255, t0 = qt * 32, i = lane & 31, hi = lane >> 5;
    bf16x8 qf[4]; load_frag4(qf, QKV + ((size_t)(36 + head) * M + (b * S + t0 + i)) * 64, hi);
    f32x16 o[2];
#pragma unroll
    for (int r = 0; r < 16; ++r) { o[0][r] = 0.f; o[1][r] = 0.f; }
    ATT_LAS const unsigned char* vb = vst + KSTAGE + (4 * hi + ((lane & 15) >> 2)) * VSTRIDE + ((lane >> 4) & 1) * 32 + (lane & 3) * 8;
    float m = NEG, zl = 0.f;
    const bf16_t* kb = MK + (size_t)(b * NMEM) * 256 + head * 64; const bf16_t* vbs = MV + (size_t)(b * NMEM) * 256 + head * 64;
    TileRegs tn;
    load_tile(tn, [&](int r) { return kb + (size_t)r * 256; }, [&](int r) { return vbs + (size_t)r * 256; }, lane);
#pragma unroll 1
    for (int kt = 0; kt < 8; ++kt) {
        const TileRegs tc = tn;
        if (kt + 1 < 8) { const int mn = 32 * (kt + 1); load_tile(tn, [&](int r) { return kb + (size_t)(mn + r) * 256; }, [&](int r) { return vbs + (size_t)(mn + r) * 256; }, lane); }
        asm volatile("s_waitcnt lgkmcnt(0)" ::: "memory");
        stage_tile(vst, tc, lane);
        asm volatile("s_waitcnt lgkmcnt(0)" ::: "memory");
        bf16x8 kf[4], vf[2][2]; read_kfrag(kf, vst, lane); read_vfrag(vf, vb);
        f32x16 p = qk_tile(kf, qf);
        softmax_step(p, m, zl, o);
        bf16x8 pw[2]; pack_p(pw, p);
        pv_mma(o, vf, pw);
    }
    float Z; { const auto rr = __builtin_amdgcn_permlane32_swap(__float_as_uint(zl), __float_as_uint(zl), false, false); Z = __uint_as_float(rr[0]) + __uint_as_float(rr[1]); }
    store_o(o, 1.0f / Z, OC + (size_t)(b * S + t0 + i) * NOC + 512 + head * 64, hi);
}
}

constexpr int RING_OFF = 0, RING_BYTES = 131072;
constexpr int LDSCTL_OFF = RING_BYTES, MISC_OFF = LDSCTL_OFF + 320;
constexpr int LDS_BYTES = 147456;
static_assert(att::LDS_BYTES <= RING_BYTES && pg8::STAGE_BYTES <= RING_BYTES && MISC_OFF + 128 <= LDS_BYTES, "LDS map");
#define GAS __attribute__((address_space(1)))
#define LAS __attribute__((address_space(3)))
typedef unsigned v4u __attribute__((ext_vector_type(4)));
typedef float f32x4 __attribute__((ext_vector_type(4)));
typedef GAS unsigned gu32;
#define LDS_WAIT() asm volatile("s_waitcnt lgkmcnt(0)" ::: "memory")
constexpr int CW_BAR = 4096;
#define XB_TMO      128
#define XB_XCNT(j)  (256  + 64 * (j))
#define XB_XSUB(j)  (1280 + 64 * (j))
#define XB_XGEN(j)  (2304 + 64 * (j))
#define XB_TOP      3328
#define XB_TOPGEN   3392
#define XCD_BAR_WORDS 3456
#define XB_SPIN_CAP (1u << 18)

__device__ __forceinline__ unsigned xb_ld(unsigned* p)              { return __hip_atomic_load(p, __ATOMIC_RELAXED, __HIP_MEMORY_SCOPE_AGENT); }
__device__ __forceinline__ unsigned xb_add(unsigned* p, unsigned v) { return __hip_atomic_fetch_add(p, v, __ATOMIC_RELAXED, __HIP_MEMORY_SCOPE_AGENT); }
__device__ __forceinline__ unsigned xb_xcc_id() { return (unsigned)__builtin_amdgcn_s_getreg((3 << 11) | 20) & 0xFu; }
#define XB_SPIN(cond, bar) do { unsigned _sp = 0; while (cond) { __builtin_amdgcn_s_sleep(1); \
    if ((++_sp & 255u) == 0u) { if (xb_ld(&(bar)[XB_TMO])) break; if (_sp > XB_SPIN_CAP) { atomicAdd(&(bar)[XB_TMO], 1u); break; } } } } while (0)

struct XcdBarrier {
    int wave; unsigned* bar; unsigned x;
    volatile LAS unsigned* st;
};

__device__ __forceinline__ bool xb_thread0(int wave) { int ln; asm volatile("v_mbcnt_lo_u32_b32 %0, -1, 0\n\tv_mbcnt_hi_u32_b32 %0, -1, %0" : "=v"(ln)); return ln == 0 && wave == 0; }
__device__ __forceinline__ XcdBarrier xcd_barrier_post(unsigned* bar, volatile LAS unsigned* st, int wave) {
    XcdBarrier b; b.wave = wave; b.bar = bar; b.x = xb_xcc_id(); b.st = st;
    if (xb_thread0(wave)) (void)xb_add(&bar[XB_XCNT(b.x)], 1u);
    return b;
}
__device__ __forceinline__ void xcd_barrier_complete(unsigned* bar, unsigned x, unsigned& nloc, unsigned& nx) {
    const unsigned G = gridDim.x * gridDim.y * gridDim.z;
    unsigned sum, cnt, mine, sp = 0u;
    for (;;) {
        sum = 0u; cnt = 0u; mine = 0u;
#pragma unroll
        for (unsigned j = 0; j < 16; ++j) { const unsigned c = xb_ld(&bar[XB_XCNT(j)]); sum += c; cnt += (c > 0u) ? 1u : 0u; mine = (j == x) ? c : mine; }
        if (sum == G) break;
        __builtin_amdgcn_s_sleep(1);
        if ((++sp & 255u) == 0u) { if (xb_ld(&bar[XB_TMO])) break; if (sp > XB_SPIN_CAP) { atomicAdd(&bar[XB_TMO], 1u); break; } }
    }
    nloc = mine > 0u ? mine : 1u; nx = cnt > 0u ? cnt : 1u;
}

__device__ __forceinline__ void xcd_barrier(const XcdBarrier& b) {
    asm volatile("s_waitcnt vmcnt(0)" ::: "memory");
    __syncthreads();
    if (xb_thread0(b.wave)) {
        unsigned* bar = b.bar;
        __builtin_amdgcn_s_waitcnt(0);
        unsigned nloc = b.st[0], nx = b.st[1];
        if (nloc == 0u) { xcd_barrier_complete(bar, b.x, nloc, nx); b.st[0] = nloc; b.st[1] = nx; }
        const unsigned old = xb_add(&bar[XB_XSUB(b.x)], 1u);
        const unsigned gen = old / nloc;
        if (old + 1u == (gen + 1u) * nloc) {
            __builtin_amdgcn_fence(__ATOMIC_RELEASE, "agent");
            asm volatile("s_waitcnt vmcnt(0)" ::: "memory");
            const unsigned og = xb_add(&bar[XB_TOP], 1u);
            const unsigned tg = og / nx;
            if (og + 1u == (tg + 1u) * nx) xb_add(&bar[XB_TOPGEN], 1u);
            else XB_SPIN(xb_ld(&bar[XB_TOPGEN]) == tg, bar);
            __builtin_amdgcn_fence(__ATOMIC_ACQUIRE, "agent");
            xb_add(&bar[XB_XGEN(b.x)], 1u);
            asm volatile("s_waitcnt vmcnt(0)" ::: "memory");
        } else {
            XB_SPIN(xb_ld(&bar[XB_XGEN(b.x)]) == gen, bar);
            __builtin_amdgcn_fence(__ATOMIC_ACQUIRE, "agent");
            asm volatile("s_waitcnt vmcnt(0)" ::: "memory");
        }
    }
    __syncthreads();

}

#ifndef PROBE_SEL
#define PROBE_SEL(b) true
#endif
#ifndef EXTRA_BAR
#define EXTRA_BAR 0
#endif
#ifndef PROBE_BLOCK
#define PROBE_BLOCK 255
#endif
#ifndef PROBE_P0
#define PROBE_P0 0
#endif
#define P0_PROBE_BEGIN(k) unsigned long long pp0_##k = 0; if (PROBE_P0 == k) pp0_##k = __builtin_amdgcn_s_memrealtime()
#define P0_PROBE_END(k) do { if (PROBE_P0 == k) { const unsigned long long t1_ = __builtin_amdgcn_s_memrealtime(), d_ = t1_ - pp0_##k; while (__builtin_amdgcn_s_memrealtime() - t1_ < d_) __builtin_amdgcn_s_sleep(8); } } while (0)
struct Frame {
    LAS unsigned char* lds;
    volatile LAS unsigned* MISC;
    gu32* ctl;
    int wave, vcu, G;
};
__device__ __forceinline__ int lane_now() { int ln; asm volatile("v_mbcnt_lo_u32_b32 %0, -1, 0\n\tv_mbcnt_hi_u32_b32 %0, -1, %0" : "=v"(ln)); return ln; }

__device__ __forceinline__ unsigned pk2(float lo, float hi) { return (unsigned)f2bf(lo) | ((unsigned)f2bf(hi) << 16); }
__device__ __forceinline__ int dest_row(int kind, int n0) {
    if (kind == 1) return n0 < FF ? (n0 >> 7) * 256 + (n0 & 127) : ((n0 - FF) >> 7) * 256 + 128 + ((n0 - FF) & 127);
    if (kind == 2) { const int l = n0 & 255;
        if (n0 < NQKV) return (n0 & ~255) + (((l >> 5) & 1) << 7) + ((l >> 6) << 5) + (l & 31);
        return (n0 & ~255) + (((l >> 3) & 1) << 7) + ((l >> 6) << 5) + (((l >> 4) & 3) << 3) + (l & 7); }
    return n0;
}
__device__ __forceinline__ void p0_item_load(f32x4 (&v)[8], const float* W, const float* gain, int N, int item, int lane) {
    const int nblk = N / 32, kb = item / nblk, nb = item % nblk, k0 = 64 * kb, n0 = 32 * nb;
#pragma unroll
    for (int i = 0; i < 8; ++i) { const int kk = 8 * i + (lane >> 3); const float g = gain ? gain[k0 + kk] : 1.0f;
        v[i] = __builtin_nontemporal_load((const GAS f32x4*)(W + (size_t)(k0 + kk) * N + n0 + 4 * (lane & 7))) * g; }
}
__device__ __forceinline__ void p0_item_finish(const f32x4 (&v)[8], int N, bf16_t* WT, int kind, int ldk, int koff, LAS float* scr, int item, int lane) {
    const int nblk = N / 32, kb = item / nblk, nb = item % nblk, k0 = 64 * kb, n0 = 32 * nb;
#pragma unroll
    for (int i = 0; i < 8; ++i) { LAS float* d = scr + (8 * i + (lane >> 3)) * 33 + 4 * (lane & 7); d[0] = v[i].x; d[1] = v[i].y; d[2] = v[i].z; d[3] = v[i].w; }
    LDS_WAIT(); asm volatile("" ::: "memory");
    const int c = lane & 7;
#pragma unroll
    for (int j = 0; j < 4; ++j) { const int n = (lane >> 3) + 8 * j, r0 = dest_row(kind, n0 + 8 * j) - 8 * j; const LAS float* s = scr + (8 * c) * 33 + n;
        v4u o; o.x = pk2(s[0 * 33], s[1 * 33]); o.y = pk2(s[2 * 33], s[3 * 33]); o.z = pk2(s[4 * 33], s[5 * 33]); o.w = pk2(s[6 * 33], s[7 * 33]);
        *(GAS v4u*)(WT + (size_t)(r0 + n) * ldk + koff + k0 + 8 * c) = o; }
    LDS_WAIT(); asm volatile("" ::: "memory");
}
__device__ __forceinline__ float wave_sum(float v) {
#pragma unroll
    for (int o = 1; o < 64; o <<= 1) v += __shfl_xor(v, o);
    return v;
}
__device__ __forceinline__ void p0_row(const float* xrow, bf16_t* orow, float* rstd, int lane) {
    const GAS f32x4* xr = (const GAS f32x4*)xrow + lane;
    f32x4 v[4]; float s = 0.f;
#pragma unroll
    for (int j = 0; j < 4; ++j) { v[j] = xr[64 * j]; s += (v[j].x * v[j].x + v[j].y * v[j].y) + (v[j].z * v[j].z + v[j].w * v[j].w); }
    s = wave_sum(s);
    GAS unsigned long long* o8 = (GAS unsigned long long*)orow + lane;
#pragma unroll
    for (int j = 0; j < 4; ++j) o8[64 * j] = (unsigned long long)pk2(v[j].x, v[j].y) | ((unsigned long long)pk2(v[j].z, v[j].w) << 32);
    if (lane == 0) *rstd = 1.0f / sqrtf(s * (1.0f / D) + EPS);
}
#ifndef USE_FOLD
#define USE_FOLD 0
#endif
#ifndef P4_REP_DIL
#define P4_REP_DIL 0
#endif
#ifndef P4_REP_MEM
#define P4_REP_MEM 0
#endif
#ifndef P4_REP_SB
#define P4_REP_SB 0
#endif
#ifndef P5_REP
#define P5_REP 0
#endif
#ifndef P0_REP_T
#define P0_REP_T 0
#endif
#ifndef P0_REP_R
#define P0_REP_R 0
#endif
struct WItem { const float* W; const float* gain; bf16_t* WT; int K, N, kind, ldk, koff; };
__device__ __forceinline__ void p0_prologue(Frame& F, const Ptrs& P) {
    unsigned char* ws = P.ws; const int lane_ = lane_now(), tid_ = F.wave * 64 + lane_;
    P0_PROBE_BEGIN(1);
    for (int u = F.vcu; u < 256; u += F.G) {
        typedef short bf16x8_t __attribute__((ext_vector_type(8))); typedef float f32x16_t __attribute__((ext_vector_type(16)));
        const int rg = u >> 3, hd = u & 7, head = hd & 3, r0 = rg * 32, kb = 128 * F.wave, mi = lane_ & 31, hi = lane_ >> 5;
        LAS float* part = (LAS float*)(F.lds + F.wave * 16384);
        f32x4 av[8][2], gv[8][2]; float wv[8][2][8];
        const float* mrow = P.mem + (size_t)(r0 + mi) * D + kb + 8 * hi; const float* grow = P.mem_norm + kb + 8 * hi;
        const float* wp = P.w_mem_kv + (size_t)(kb + 8 * hi) * 512 + hd * 64 + mi;
#pragma unroll
        for (int s = 0; s < 8; ++s) { av[s][0] = *(const GAS f32x4*)(mrow + 16 * s); av[s][1] = *(const GAS f32x4*)(mrow + 16 * s + 4); gv[s][0] = *(const GAS f32x4*)(grow + 16 * s); gv[s][1] = *(const GAS f32x4*)(grow + 16 * s + 4);
#pragma unroll
            for (int t = 0; t < 2; ++t)
#pragma unroll
                for (int j = 0; j < 8; ++j) wv[s][t][j] = wp[(size_t)(16 * s + j) * 512 + 32 * t]; }
        f32x16_t acc[2]; float sq = 0.f;
#pragma unroll
        for (int r = 0; r < 16; ++r) { acc[0][r] = 0.f; acc[1][r] = 0.f; }
#pragma unroll
        for (int s = 0; s < 8; ++s) { const f32x4 a0 = av[s][0], a1 = av[s][1]; sq += (a0.x * a0.x + a0.y * a0.y) + (a0.z * a0.z + a0.w * a0.w) + (a1.x * a1.x + a1.y * a1.y) + (a1.z * a1.z + a1.w * a1.w);
            const f32x4 b0 = a0 * gv[s][0], b1 = a1 * gv[s][1];
            const v4u bw = {pk2(b0.x, b0.y), pk2(b0.z, b0.w), pk2(b1.x, b1.y), pk2(b1.z, b1.w)};
#pragma unroll
            for (int t = 0; t < 2; ++t) { const v4u aw = {pk2(wv[s][t][0], wv[s][t][1]), pk2(wv[s][t][2], wv[s][t][3]), pk2(wv[s][t][4], wv[s][t][5]), pk2(wv[s][t][6], wv[s][t][7])};
                acc[t] = __builtin_amdgcn_mfma_f32_32x32x16_bf16(__builtin_bit_cast(bf16x8_t, aw), __builtin_bit_cast(bf16x8_t, bw), acc[t], 0, 0, 0); } }
#pragma unroll
        for (int t = 0; t < 2; ++t)
#pragma unroll
            for (int r = 0; r < 16; ++r) part[(t * 16 + r) * 64 + lane_] = acc[t][r];
        part[2048 + lane_] = sq;
        __syncthreads();
        if (F.wave == 0) {
            float v[2][16]; float q = 0.f;
#pragma unroll
            for (int t = 0; t < 2; ++t)
#pragma unroll
                for (int r = 0; r < 16; ++r) { float s = 0.f;
#pragma unroll
                    for (int w8 = 0; w8 < 8; ++w8) s += ((const LAS float*)(F.lds + w8 * 16384))[(t * 16 + r) * 64 + lane_];
                    v[t][r] = s; }
#pragma unroll
            for (int w8 = 0; w8 < 8; ++w8) q += ((const LAS float*)(F.lds + w8 * 16384))[2048 + lane_];
            q += __shfl_xor(q, 32);
            const float rs = 1.0f / sqrtf(q * (1.0f / D) + EPS);
            float hs = 0.f;
#pragma unroll
            for (int t = 0; t < 2; ++t)
#pragma unroll
                for (int r = 0; r < 16; ++r) { v[t][r] *= rs; hs += v[t][r] * v[t][r]; }
            hs += __shfl_xor(hs, 32);
            const float hr = 1.0f / sqrtf(hs * (1.0f / HD) + EPS);
            bf16_t* orow = (bf16_t*)(ws + (hd < 4 ? WS_MK : WS_MVT)) + (size_t)(r0 + mi) * 256 + head * 64;
#pragma unroll
            for (int t = 0; t < 2; ++t)
#pragma unroll
                for (int g4 = 0; g4 < 4; ++g4) { const int n0 = 32 * t + 8 * g4 + 4 * hi; float o4[4];
#pragma unroll
                    for (int i = 0; i < 4; ++i) o4[i] = hd < 4 ? v[t][4 * g4 + i] * hr * P.x_k_gain[n0 + i] : v[t][4 * g4 + i];
                    *(unsigned long long*)(orow + n0) = (unsigned long long)pk2(o4[0], o4[1]) | ((unsigned long long)pk2(o4[2], o4[3]) << 32); }
        }
        __syncthreads();
    }
    P0_PROBE_END(1);
    if (F.vcu == 0 && tid_ < 129) { float* BIAS = (float*)(ws + WS_BIAS);
        for (int g = 0; g < 3; ++g) for (int hh = 0; hh < 2; ++hh) BIAS[(g * 2 + hh) * 129 + tid_] = P.rel_bias[T5B[g][tid_] * 6 + g * 2 + hh] * LOG2E; }
    LAS float* scr = (LAS float*)(F.lds + F.wave * 16384);
    const int gw = F.vcu * 8 + F.wave, NGW = F.G * 8;
    const WItem items[9] = {
        {P.ffn1_w_gu, P.ffn1_norm, (bf16_t*)(ws + WS_WGU1), D, NGU, 1, D, 0}, {P.w_in, P.mix_norm, (bf16_t*)(ws + WS_WIN), D, INCOLS, 2, D, 0}, {P.ffn2_w_gu, P.ffn2_norm, (bf16_t*)(ws + WS_WGU2), D, NGU, 1, D, 0},
        {P.ffn1_w_down, nullptr, (bf16_t*)(ws + WS_WD1), FF, D, 0, FF, 0}, {P.ffn2_w_down, nullptr, (bf16_t*)(ws + WS_WD2), FF, D, 0, FF, 0}, {P.w_out, nullptr, (bf16_t*)(ws + WS_WOUT), D, D, 0, D, 0},
        {P.w_br_sb, nullptr, (bf16_t*)(ws + WS_WSB), 384, D, 0, NOC, 0}, {P.w_br_dil, nullptr, (bf16_t*)(ws + WS_WSB), 128, D, 0, NOC, 384}, {P.w_br_x, nullptr, (bf16_t*)(ws + WS_WSB), 256, D, 0, NOC, 512}};
    P0_PROBE_BEGIN(2);
    {
        int cum[10]; cum[0] = 0;
#pragma unroll
        for (int w = 0; w < 9; ++w) cum[w + 1] = cum[w] + (items[w].K / 64) * (items[w].N / 32);
        const int total = cum[9];
        f32x4 va[8], vb[8];
#define P0_LOCATE(G_, w_) int w_ = 0; _Pragma("unroll") for (int q_ = 1; q_ < 9; ++q_) w_ += ((G_) >= cum[q_]) ? 1 : 0
#define P0_LOAD(V_, G_) do { P0_LOCATE(G_, w__); const float* W__ = items[0].W; const float* g__ = items[0].gain; int N__ = items[0].N, c__ = 0; \
            _Pragma("unroll") for (int q_ = 1; q_ < 9; ++q_) if (w__ == q_) { W__ = items[q_].W; g__ = items[q_].gain; N__ = items[q_].N; c__ = cum[q_]; } \
            p0_item_load(V_, W__, g__, N__, (G_) - c__, lane_); } while (0)
#define P0_FINISH(V_, G_) do { P0_LOCATE(G_, w__); bf16_t* T__ = items[0].WT; int N__ = items[0].N, k__ = items[0].kind, l__ = items[0].ldk, o__ = items[0].koff, c__ = 0; \
            _Pragma("unroll") for (int q_ = 1; q_ < 9; ++q_) if (w__ == q_) { T__ = items[q_].WT; N__ = items[q_].N; k__ = items[q_].kind; l__ = items[q_].ldk; o__ = items[q_].koff; c__ = cum[q_]; } \
            p0_item_finish(V_, N__, T__, k__, l__, o__, scr, (G_) - c__, lane_); } while (0)
        int G = gw;
        if (G < total) P0_LOAD(va, G);
        for (; G < total; G += 2 * NGW) {
            if (G + NGW < total) P0_LOAD(vb, G + NGW);
            P0_FINISH(va, G);
            if (G + NGW < total) { if (G + 2 * NGW < total) P0_LOAD(va, G + 2 * NGW); P0_FINISH(vb, G + NGW); }
        }
#undef P0_LOCATE
#undef P0_LOAD
#undef P0_FINISH
    }
    P0_PROBE_END(2);
    P0_PROBE_BEGIN(3);
    for (int m = gw; m < M; m += 4 * NGW) {
        f32x4 v[4][4];
#pragma unroll
        for (int q = 0; q < 4; ++q) { const int mq = (m + q * NGW < M) ? m + q * NGW : m; const GAS f32x4* xr = (const GAS f32x4*)(P.x + (size_t)mq * D) + lane_;
#pragma unroll
            for (int j = 0; j < 4; ++j) v[q][j] = __builtin_nontemporal_load(xr + 64 * j); }
#pragma unroll
        for (int q = 0; q < 4; ++q) { const int mq = m + q * NGW; if (mq < M) { float s = 0.f;
#pragma unroll
            for (int j = 0; j < 4; ++j) s += (v[q][j].x * v[q][j].x + v[q][j].y * v[q][j].y) + (v[q][j].z * v[q][j].z + v[q][j].w * v[q][j].w);
            s = wave_sum(s);
            GAS unsigned long long* o8 = (GAS unsigned long long*)((bf16_t*)(ws + WS_XB) + (size_t)mq * D) + lane_;
#pragma unroll
            for (int j = 0; j < 4; ++j) o8[64 * j] = (unsigned long long)pk2(v[q][j].x, v[q][j].y) | ((unsigned long long)pk2(v[q][j].z, v[q][j].w) << 32);
            if (lane_ == 0) ((float*)(ws + WS_RSTD0))[mq] = 1.0f / sqrtf(s * (1.0f / D) + EPS); } }
    }
    P0_PROBE_END(3);
}

#ifndef PROBE_PHASE
#define PROBE_PHASE -1
#endif
#ifndef REP_MASK
#define REP_MASK 0x0
#endif
constexpr int NPHASE = 9;
struct Args { Ptrs P; int ph_lo, ph_hi, use_bar, rep; };
__global__ void __launch_bounds__(512, 2) mega_fwd(Args args) {
    extern __shared__ __attribute__((aligned(16))) unsigned char lds[];
    Frame F;
    F.lds = (LAS unsigned char*)lds;
    F.MISC = (volatile LAS unsigned*)(F.lds + MISC_OFF);
    F.wave = __builtin_amdgcn_readfirstlane(threadIdx.x >> 6);
    F.G = gridDim.x; { const int bx = blockIdx.x; F.vcu = (F.G % 8 == 0) ? (bx % 8) * (F.G / 8) + bx / 8 : bx; }
    const Ptrs& P = args.P;
    unsigned char* ws = P.ws;
    F.ctl = (gu32*)(ws + WS_CTL);
    for (int u = F.wave * 64 + lane_now(); u < (LDS_BYTES - LDSCTL_OFF) / 4; u += 512) ((LAS unsigned*)(F.lds + LDSCTL_OFF))[u] = 0u;
    __syncthreads();
    XcdBarrier bar; bar.wave = F.wave; bar.bar = (unsigned*)(F.ctl + CW_BAR); bar.x = 0; bar.st = nullptr;
    if (args.use_bar) bar = xcd_barrier_post((unsigned*)(F.ctl + CW_BAR), F.MISC + 8, F.wave);
    const int lo = args.ph_lo, hi = args.ph_hi;
#define IN(k) (lo <= (k) && (k) < hi)
#define SEAM(k) do { if (IN(k) && IN((k) + 1)) { xcd_barrier(bar); if (EXTRA_BAR) xcd_barrier(bar); } PROBE_AT(k); } while (0)
#if PROBE_PHASE >= 0
    unsigned long long pr_t0 = __builtin_amdgcn_s_memrealtime();
#define PROBE_AT(k) do { if ((k) + 1 == PROBE_PHASE) pr_t0 = __builtin_amdgcn_s_memrealtime(); \
        if ((k) == PROBE_PHASE) { if (PROBE_SEL(blockIdx.x)) { const unsigned long long t1_ = __builtin_amdgcn_s_memrealtime(), d_ = t1_ - pr_t0; while (__builtin_amdgcn_s_memrealtime() - t1_ < d_) __builtin_amdgcn_s_sleep(8); __syncthreads(); } } } while (0)
#else
#define PROBE_AT(k) do { } while (0)
#endif
    bf16_t *XB = (bf16_t*)(ws + WS_XB), *OC = (bf16_t*)P.out  , *H = (bf16_t*)(ws + WS_BIG), *QKV = H; unsigned char* G = ws + WS_G;
    bf16_t* MERGED = (bf16_t*)(ws + WS_BIG + 64 * MiB);
    bf16_t* MACC = (bf16_t*)(ws + WS_BIG); float *SS1 = (float*)(ws + WS_SS1), *SS2 = (float*)(ws + WS_SS2), *RSTD0 = (float*)(ws + WS_RSTD0);
    const int cblk = (int)blockIdx.x;

    _Pragma("unroll") for (int rp_ = 0; rp_ <= ((REP_MASK >> 0) & 1); ++rp_) if (IN(0)) { if (rp_) xcd_barrier(bar); p0_prologue(F, P); } SEAM(0);
    _Pragma("unroll") for (int rp_ = 0; rp_ <= ((REP_MASK >> 1) & 1); ++rp_) if (IN(1)) { if (rp_) xcd_barrier(bar); pg8::Gemm g{XB, (const bf16_t*)(ws + WS_WGU1), M, NGU, D, D, D}; pg8::StaticOrder So; So.init(M, NGU, F.G, cblk);
        pg8::EpiFfnUp E{H, RSTD0, nullptr}; pg8::gemm_phase(F.lds, g, So, E, F.wave); } SEAM(1);
    _Pragma("unroll") for (int rp_ = 0; rp_ <= ((REP_MASK >> 2) & 1); ++rp_) if (IN(2)) { if (rp_) xcd_barrier(bar); pg8::Gemm g{H, (const bf16_t*)(ws + WS_WD1), M, D, FF, FF, FF}; pg8::StaticOrder So; So.init(M, D, F.G, cblk);
        pg8::EpiResB E{XB, SS1, 0.5f};   pg8::gemm_phase(F.lds, g, So, E, F.wave); } SEAM(2);
    _Pragma("unroll") for (int rp_ = 0; rp_ <= ((REP_MASK >> 3) & 1); ++rp_) if (IN(3)) { if (rp_) xcd_barrier(bar); pg8::Gemm g{XB, (const bf16_t*)(ws + WS_WIN), M, INCOLS, D, D, D}; pg8::StaticOrder So; So.init(M, INCOLS, F.G, cblk);
        pg8::EpiWin E{QKV, G, SS1, P.dil_q_gain, P.dil_k_gain, P.x_q_gain, nullptr, (bf16_t*)(ws + 57 * MiB)}; pg8::gemm_phase(F.lds, g, So, E, F.wave); } SEAM(3);
    _Pragma("unroll") for (int rp_ = 0; rp_ <= ((REP_MASK >> 4) & 1); ++rp_) if (IN(4)) { if (rp_) xcd_barrier(bar);
        LAS float* tbl = (LAS float*)(F.lds + att::LDS_TBL); const float* BIAS = (const float*)(ws + WS_BIAS); const int lane_ = lane_now();
        for (int e = F.wave * 64 + lane_; e < 6 * att::TBLN; e += 512) { const int t = e / att::TBLN, s = e % att::TBLN; tbl[e] = (s >= 1 && s <= 129) ? BIAS[t * 129 + s - 1] : att::NEG; }
        __syncthreads();
        LAS unsigned char* vst = F.lds + att::LDS_VST + F.wave * att::WSTAGE;
        const int gw = F.vcu * 8 + F.wave, NGW = F.G * 8;
        if (F.G == 256) {
            bf16_t* PART = (bf16_t*)((unsigned char*)P.out + 64 * MiB); float* LSE = (float*)((unsigned char*)P.out + 96 * MiB);
            const bool dilb = F.vcu < 128; const int v2 = F.vcu - 128;
            P0_PROBE_BEGIN(31);
            if (dilb) { const int b = F.vcu >> 5, hh = (F.vcu >> 4) & 1, span = F.vcu & 15;
                for (int k = 0; k < 6; ++k) { const int wu = F.wave + 8 * k;
                    if (wu < 16) att::dilg_unit(b, hh, 0, 0, span * 16 + wu, QKV, PART, LSE, tbl, vst, lane_);
                    else if (wu < 32) att::dilg_unit(b, hh, 1, (wu - 16) & 3, span * 4 + ((wu - 16) >> 2), QKV, PART, LSE, tbl, vst, lane_);
                    else att::dilg_unit(b, hh, 2, wu - 32, span, QKV, PART, LSE, tbl, vst, lane_); }
            }
            P0_PROBE_END(31);
            const int nsb = dilb ? 2 : 4, sb0 = dilb ? F.vcu * 2 : 256 + v2 * 4, nme = dilb ? 1 : 3, me0 = dilb ? F.vcu : 128 + v2 * 3;
            P0_PROBE_BEGIN(32);
            for (int j = 0; j < nme; ++j) att::mem_unit((me0 + j) * 8 + F.wave, QKV, (const bf16_t*)(ws + WS_MK), (const bf16_t*)(ws + WS_MVT), OC, vst, lane_);
            P0_PROBE_END(32);
            P0_PROBE_BEGIN(33);
            for (int j = 0; j < nsb; ++j) att::sb_unit((sb0 + j) * 8 + F.wave, QKV, OC, vst, lane_);
            P0_PROBE_END(33);
            if (dilb) { asm volatile("s_waitcnt vmcnt(0)" ::: "memory"); __syncthreads();
                att::dil_combine(F.vcu >> 5, (F.vcu >> 4) & 1, (F.vcu & 15) * 512 + F.wave * 64, 64, PART, LSE, OC, lane_); }
        } else {
            for (int id = gw; id < 2048; id += NGW) att::dil_unit(id, QKV, OC, tbl, vst, lane_);
            for (int id = gw; id < 4096; id += NGW) att::mem_unit(id, QKV, (const bf16_t*)(ws + WS_MK), (const bf16_t*)(ws + WS_MVT), OC, vst, lane_);
            for (int id = gw; id < 6144; id += NGW) att::sb_unit(id, QKV, OC, vst, lane_);
        }
        asm volatile("s_waitcnt vmcnt(0) lgkmcnt(0)" ::: "memory"); __syncthreads();
    } SEAM(4);
    _Pragma("unroll") for (int rp_ = 0; rp_ <= ((REP_MASK >> 5) & 1); ++rp_) if (IN(5)) { if (rp_) xcd_barrier(bar);
        pg8::ChainOrder<0, 6, 384, 2, 512, 4> So; So.init(M, D, F.G, cblk);
        pg8::Gemm g{OC, (const bf16_t*)(ws + WS_WSB), M, D, NOC, NOC, NOC}; pg8::EpiBranchChain E{G, MACC, MERGED}; pg8::gemm_phase(F.lds, g, So, E, F.wave); } SEAM(5);
    _Pragma("unroll") for (int rp_ = 0; rp_ <= ((REP_MASK >> 6) & 1); ++rp_) if (IN(6)) { if (rp_) xcd_barrier(bar); pg8::Gemm g{MERGED, (const bf16_t*)(ws + WS_WOUT), M, D, D, D, D}; pg8::StaticOrder So; So.init(M, D, F.G, cblk);
        pg8::EpiResB E{XB, SS2, 1.0f}; pg8::gemm_phase(F.lds, g, So, E, F.wave); } SEAM(6);
    _Pragma("unroll") for (int rp_ = 0; rp_ <= ((REP_MASK >> 7) & 1); ++rp_) if (IN(7)) { if (rp_) xcd_barrier(bar); pg8::Gemm g{XB, (const bf16_t*)(ws + WS_WGU2), M, NGU, D, D, D}; pg8::StaticOrder So; So.init(M, NGU, F.G, cblk);
        pg8::EpiFfnUp E{H, nullptr, SS2}; pg8::gemm_phase(F.lds, g, So, E, F.wave); } SEAM(7);
    _Pragma("unroll") for (int rp_ = 0; rp_ <= ((REP_MASK >> 8) & 1); ++rp_) if (IN(8)) { if (rp_) xcd_barrier(bar); pg8::Gemm g{H, (const bf16_t*)(ws + WS_WD2), M, D, FF, FF, FF}; pg8::StaticOrder So; So.init(M, D, F.G, cblk);
        pg8::EpiResOut E{XB, P.out, 0.5f}; pg8::gemm_phase(F.lds, g, So, E, F.wave); }
    PROBE_AT(8);
#undef IN
#undef SEAM
}

extern "C" void kernel_launch(void* const* d_in, const int* in_sizes, int n_in, void* d_out, int out_size, void* d_ws, size_t ws_size, hipStream_t stream) {
    static int grid = 0;
    if (grid == 0) {
        if (n_in != 21 || out_size != M * D || ws_size < WS_END) { fprintf(stderr, "kernel_launch: unexpected shapes (n_in %d out %d ws %zu)\n", n_in, out_size, ws_size); grid = -1; return; }
        int dev = 0, cus = 0, per_cu = 0;
        if (hipGetDevice(&dev) != hipSuccess || hipDeviceGetAttribute(&cus, hipDeviceAttributeMultiprocessorCount, dev) != hipSuccess) { grid = -1; return; }
        if (hipFuncSetAttribute((const void*)mega_fwd, hipFuncAttributeMaxDynamicSharedMemorySize, LDS_BYTES) != hipSuccess) { fprintf(stderr, "kernel_launch: hipFuncSetAttribute failed\n"); grid = -1; return; }
        if (hipOccupancyMaxActiveBlocksPerMultiprocessor(&per_cu, (const void*)mega_fwd, 512, LDS_BYTES) != hipSuccess || per_cu < 1) { fprintf(stderr, "kernel_launch: occupancy query says %d blocks per CU\n", per_cu); grid = -1; (void)hipGetLastError(); return; }
        (void)hipGetLastError();
        grid = cus;
    }
    if (grid < 0) return;
    Args a{};
    { const float** pp = (const float**)&a.P; for (int i = 0; i < 21; ++i) pp[i] = (const float*)d_in[i]; }
    a.P.out = (float*)d_out; a.P.ws = (unsigned char*)d_ws;
    unsigned char* ws = a.P.ws;
    (void)hipMemsetAsync(ws + WS_CTL, 0, CTL_ZERO_BYTES, stream);
    a.ph_lo = 0; a.ph_hi = NPHASE; a.use_bar = 1;
    hipLaunchKernelGGL(mega_fwd, dim3(grid), dim3(512), LDS_BYTES, stream, a);
    return;
}
```

```cpp
#include <hip/hip_runtime.h>
#include <cstdint>
#include <cstdio>

constexpr int NB = 4, S = 8192, D = 1024, M = NB * S;
constexpr int FF = 2816, NGU = 2 * FF;
constexpr int HD = 64;
constexpr int NQKV = 2560, NGATE = 3072, INCOLS = NQKV + NGATE;
constexpr int QKVP = 2624;
constexpr int NMEM = 256, MROWS = NB * NMEM;
constexpr int NOC = 768;
constexpr float EPS = 1e-6f;
constexpr float LOG2E = 1.4426950408889634f;
constexpr float QSCALE = 0.125f * LOG2E;

typedef unsigned short bf16_t;
__device__ __forceinline__ float bf2f(bf16_t v) { return __uint_as_float(((unsigned)v) << 16); }
__device__ __forceinline__ bf16_t f2bf(float f) { unsigned u = __float_as_uint(f); return (bf16_t)((u + 0x7fffu + ((u >> 16) & 1u)) >> 16); }

constexpr size_t MiB = 1u << 20;
constexpr size_t WS_CTL = 0, CTL_ZERO_BYTES = 1 * MiB;
constexpr size_t WS_SS1 = 256 * 1024, WS_SS2 = 384 * 1024, WS_RSTD0 = 512 * 1024, WS_BIAS = 768 * 1024;
constexpr size_t WS_WGU1 = 2 * MiB, WS_WD1 = 13 * MiB, WS_WIN = 19 * MiB, WS_WGU2 = 30 * MiB, WS_WD2 = 41 * MiB, WS_WOUT = 47 * MiB, WS_WSB = 49 * MiB  , WS_WDIL = 51 * MiB, WS_WX = 52 * MiB, WS_WSB2 = 53 * MiB;
constexpr size_t WS_MK = 54 * MiB, WS_MVT = 55 * MiB;
constexpr size_t WS_XB = 64 * MiB;
constexpr size_t WS_BIG = 128 * MiB;
constexpr size_t WS_G = 296 * MiB;
constexpr size_t WS_END = 488 * MiB;
static_assert(WS_WGU1 + (size_t)NGU * D * 2 <= WS_WD1 && WS_WD1 + (size_t)D * FF * 2 <= WS_WIN && WS_WIN + (size_t)INCOLS * D * 2 <= WS_WGU2 && WS_WGU2 + (size_t)NGU * D * 2 <= WS_WD2 &&
              WS_WD2 + (size_t)D * FF * 2 <= WS_WOUT && WS_WOUT + (size_t)D * D * 2 <= WS_WSB && WS_XB + (size_t)M * D * 2 <= WS_BIG && WS_BIG + (size_t)M * QKVP * 2 <= WS_G && WS_G + (size_t)M * NGATE * 2 <= WS_END, "d_ws map");

__device__ const unsigned char T5B[3][129] = {
 {0,1,2,3,4,5,6,7,8,9,10,11,12,13,14,15,16,16,16,16,16,16,17,17,17,17,17,17,17,17,18,18,18,18,18,18,18,18,18,18,19,19,19,19,19,19,19,19,19,19,19,19,19,19,20,20,20,20,20,20,20,20,20,20,20,20,20,20,20,20,20,20,20,21,21,21,21,21,21,21,21,21,21,21,21,21,21,21,21,21,21,21,21,21,21,21,21,21,21,22,22,22,22,22,22,22,22,22,22,22,22,22,22,22,22,22,22,22,22,22,22,22,22,22,22,22,22,22,22},
 {0,4,8,12,16,16,17,17,18,18,19,19,19,19,20,20,20,20,20,21,21,21,21,21,21,22,22,22,22,22,22,22,22,22,23,23,23,23,23,23,23,23,23,23,23,23,24,24,24,24,24,24,24,24,24,24,24,24,24,24,24,24,25,25,25,25,25,25,25,25,25,25,25,25,25,25,25,25,25,25,25,25,25,26,26,26,26,26,26,26,26,26,26,26,26,26,26,26,26,26,26,26,26,26,26,26,26,26,26,26,26,26,26,27,27,27,27,27,27,27,27,27,27,27,27,27,27,27,27},
 {0,16,18,19,20,21,21,22,22,23,23,23,24,24,24,24,25,25,25,25,25,26,26,26,26,26,26,26,26,27,27,27,27,27,27,27,27,27,27,28,28,28,28,28,28,28,28,28,28,28,28,28,29,29,29,29,29,29,29,29,29,29,29,29,29,29,29,29,29,29,30,30,30,30,30,30,30,30,30,30,30,30,30,30,30,30,30,30,30,30,30,30,30,30,30,31,31,31,31,31,31,31,31,31,31,31,31,31,31,31,31,31,31,31,31,31,31,31,31,31,31,31,31,31,31,31,31,31,31}};

struct Ptrs {
    const float *x, *mem, *rel_bias, *ffn1_norm, *ffn1_w_gu, *ffn1_w_down, *mix_norm, *mem_norm, *w_in, *w_mem_kv,
                *dil_q_gain, *dil_k_gain, *x_q_gain, *x_k_gain, *w_br_sb, *w_br_dil, *w_br_x, *w_out, *ffn2_norm, *ffn2_w_gu, *ffn2_w_down;
    float* out; unsigned char* ws;
};

#ifndef PG8_USE_SP2
#define PG8_USE_SP2 1
#endif
namespace pg8 {
#define PG8_LAS __attribute__((address_space(3)))
typedef short bf16x8 __attribute__((ext_vector_type(8)));
typedef float f32x4 __attribute__((ext_vector_type(4)));
typedef float f32x2 __attribute__((ext_vector_type(2)));
typedef unsigned u32x4 __attribute__((ext_vector_type(4)));
typedef unsigned u32x2 __attribute__((ext_vector_type(2)));
constexpr int BM = 256, BK = 64, HALF = 128, HTB = HALF * BK * 2  , STAGE_BYTES = 8 * HTB, NXCD = 8, WGM = 8;

__host__ __device__ __forceinline__ int lds_byte(int r, int c) { const int st = (r >> 4) * 2 + (c >> 5), rr = r & 15, cc = c & 31, ob = rr * 64 + cc * 2; return st * 1024 + (ob ^ (((ob >> 9) & 1) << 5)); }
__host__ __device__ __forceinline__ void stage_rc(int b, int& R, int& C) { const int st = b / 1024, sb = b % 1024, swz = sb ^ (((sb >> 9) & 1) << 5); R = (st >> 1) * 16 + swz / 64; C = (st & 1) * 32 + (swz % 64) / 2; }
__host__ __device__ __forceinline__ int perm32(int rho) { const int n = rho >> 4, i = rho & 15; return 8 * (i >> 2) + 4 * n + (i & 3); }

struct Unit { int pm, pn, koff, ntu, step; };
struct Gemm { const bf16_t* A; const bf16_t* Bt; int M, N, K, lda, ldb; };

struct StaticOrder {
    int nM, nN, nwg, G, c;
    __host__ __device__ void init(int M_, int N_, int G_, int c_) { nM = M_ / BM; nN = N_ / BM; nwg = nM * nN; G = G_; c = c_; }
    __host__ __device__ bool next(int i, Unit& u) const {
        const long L = (long)i * G + c; if (L >= nwg) return false;
        int wgid = (int)L; { const int q = nwg / NXCD, r = nwg % NXCD, xcd = wgid % NXCD, off = wgid / NXCD; wgid = (xcd < r ? xcd * (q + 1) : r * (q + 1) + (xcd - r) * q) + off; }
        const int nig = WGM * nN, gid = wgid / nig, fm = gid * WGM, gsz = (nM - fm) < WGM ? (nM - fm) : WGM;
        u.pm = fm + ((wgid % nig) % gsz); u.pn = (wgid % nig) / gsz; u.koff = 0; u.ntu = 0; u.step = 0; return true;
    }
};

template <int K0, int N0, int K1, int N1, int K2, int N2> struct ChainOrder {
    StaticOrder S; int per;
    __host__ __device__ void init(int M_, int N_, int G_, int c_) { S.init(M_, N_, G_, c_); per = (S.nwg - c_ + G_ - 1) / G_; if (per < 0) per = 0; }
    __host__ __device__ bool next(int i, Unit& u) const { if (per == 0 || i >= 3 * per) return false; int s = 0, j = i; if (j >= per) { j -= per; s = 1; } if (j >= per) { j -= per; s = 2; }
        if (!S.next(j, u)) return false;
        int ko = K0, nu = N0; if (s == 1) { ko = K1; nu = N1; } if (s == 2) { ko = K2; nu = N2; }
        u.koff = ko; u.ntu = nu; u.step = s; return true; }
};

typedef float f32x2_t __attribute__((ext_vector_type(2))); typedef __bf16 bf16x2_t __attribute__((ext_vector_type(2)));
__device__ __forceinline__ unsigned cvt_pk_bf16(float lo, float hi) { const f32x2_t v = {lo, hi}; return __builtin_bit_cast(unsigned, __builtin_convertvector(v, bf16x2_t)); }
__device__ __forceinline__ float fast_sigmoid(float v) { return __builtin_amdgcn_rcpf(1.0f + __builtin_amdgcn_exp2f(-LOG2E * v)); }
__device__ __forceinline__ float sum_fq(float s) {
    const auto a = __builtin_amdgcn_permlane16_swap(__float_as_uint(s), __float_as_uint(s), false, false); s = __uint_as_float(a[0]) + __uint_as_float(a[1]);
    const auto b = __builtin_amdgcn_permlane32_swap(__float_as_uint(s), __float_as_uint(s), false, false); return __uint_as_float(b[0]) + __uint_as_float(b[1]); }
__device__ __forceinline__ void store16_wt(void* ptr, u32x4 v) { asm volatile("global_store_dwordx4 %0, %1, off sc1\n\ts_nop 1" :: "v"(ptr), "v"(v) : "memory"); }
__device__ __forceinline__ unsigned gate_q4(f32x4 v) { unsigned w = 0;
#pragma unroll
    for (int i = 0; i < 4; ++i) w = __builtin_amdgcn_cvt_pk_u8_f32(v[i] * 16.0f + 128.0f, i, w);
    return w; }
__device__ __forceinline__ f32x4 gate_dq4(unsigned w) { f32x4 g;
#pragma unroll
    for (int i = 0; i < 4; ++i) g[i] = ((float)((w >> (8 * i)) & 255u) - 128.0f) * 0.0625f;
    return g; }
__device__ __forceinline__ float row_rstd(const float* rstd, const float* ss, int row) { return rstd ? rstd[row] : __builtin_amdgcn_rsqf(ss[row] * (1.0f / D) + EPS); }

struct RowPre { float r[2][4]; };
struct EpiFfnUp {
    static constexpr bool PERM = true, FOLD = false, EPI_TWICE = false, EPI_DRY = false; static constexpr int TOUCH = 0;
    bf16_t* H; const float* rstd; const float* ss;
    static constexpr bool PRE = true;
    __device__ __forceinline__ RowPre pre(const Unit& u, int wr, int fr) const { RowPre q; const int row0 = u.pm * BM + wr * 64 + fr;
#pragma unroll
        for (int ai = 0; ai < 2; ++ai)
#pragma unroll
            for (int m = 0; m < 4; ++m) q.r[ai][m] = rstd ? rstd[row0 + ai * HALF + m * 16] : ss[row0 + ai * HALF + m * 16];
        return q; }
    __device__ __forceinline__ void operator()(const f32x4 (&acc)[2][2][4][2], const Unit& u, int wr, int wc, int fr, int fq, const RowPre& q) const {
        const int row0 = u.pm * BM + wr * 64 + fr, col0 = u.pn * 128 + wc * 32 + 8 * fq;
#pragma unroll
        for (int ai = 0; ai < 2; ++ai)
#pragma unroll
            for (int m = 0; m < 4; ++m) { const int row = row0 + ai * HALF + m * 16; const float r = rstd ? q.r[ai][m] : __builtin_amdgcn_rsqf(q.r[ai][m] * (1.0f / D) + EPS); float h[8];
#pragma unroll
                for (int n = 0; n < 2; ++n)
#pragma unroll
                    for (int i = 0; i < 4; ++i) { const float a = acc[ai][0][m][n][i] * r, b = acc[ai][1][m][n][i] * r; h[n * 4 + i] = a * fast_sigmoid(a) * b; }
                u32x4 w; w.x = cvt_pk_bf16(h[0], h[1]); w.y = cvt_pk_bf16(h[2], h[3]); w.z = cvt_pk_bf16(h[4], h[5]); w.w = cvt_pk_bf16(h[6], h[7]);
                store16_wt((void*)(H + (size_t)row * FF + col0), w); }
    }
};
struct EpiResOut {
    static constexpr bool PRE = false, PERM = true, FOLD = false, EPI_TWICE = false, EPI_DRY = false; static constexpr int TOUCH = 0;
    const bf16_t* xb; float* out; float alpha;
    __device__ __forceinline__ void operator()(const f32x4 (&acc)[2][2][4][2], const Unit& u, int wr, int wc, int fr, int fq) const {
        const int row0 = u.pm * BM + wr * 64 + fr, col0 = u.pn * BM + wc * 32 + 8 * fq;
        u32x4 rv[2][4][2];
#pragma unroll
        for (int ai = 0; ai < 2; ++ai)
#pragma unroll
            for (int m = 0; m < 4; ++m)
#pragma unroll
                for (int bj = 0; bj < 2; ++bj) rv[ai][m][bj] = *(const u32x4*)(xb + (size_t)(row0 + ai * HALF + m * 16) * D + col0 + bj * HALF);
        asm volatile("" ::: "memory");
#pragma unroll
        for (int ai = 0; ai < 2; ++ai)
#pragma unroll
            for (int m = 0; m < 4; ++m) { float* orow = out + (size_t)(row0 + ai * HALF + m * 16) * D + col0;
#pragma unroll
                for (int bj = 0; bj < 2; ++bj) { const u32x4 r = rv[ai][m][bj];
                    const f32x4 r0 = {__uint_as_float(r.x << 16), __uint_as_float(r.x & 0xffff0000u), __uint_as_float(r.y << 16), __uint_as_float(r.y & 0xffff0000u)};
                    const f32x4 r1 = {__uint_as_float(r.z << 16), __uint_as_float(r.z & 0xffff0000u), __uint_as_float(r.w << 16), __uint_as_float(r.w & 0xffff0000u)};
                    *(f32x4*)(orow + bj * HALF) = r0 + acc[ai][bj][m][0] * alpha; *(f32x4*)(orow + bj * HALF + 4) = r1 + acc[ai][bj][m][1] * alpha; } }
        asm volatile("" ::: "memory");
    }
};
struct EpiResB {
    static constexpr bool PRE = false, PERM = true, FOLD = false, EPI_TWICE = false, EPI_DRY = false; static constexpr int TOUCH = 0;
    bf16_t* xb; float* ss; float alpha;
    __device__ __forceinline__ void operator()(const f32x4 (&acc)[2][2][4][2], const Unit& u, int wr, int wc, int fr, int fq) const {
        const int row0 = u.pm * BM + wr * 64 + fr, col0 = u.pn * BM + wc * 32 + 8 * fq;
        u32x4 rv[2][4][2];
#pragma unroll
        for (int ai = 0; ai < 2; ++ai)
#pragma unroll
            for (int m = 0; m < 4; ++m)
#pragma unroll
                for (int bj = 0; bj < 2; ++bj) rv[ai][m][bj] = *(const u32x4*)(xb + (size_t)(row0 + ai * HALF + m * 16) * D + col0 + bj * HALF);
        asm volatile("" ::: "memory");
#pragma unroll
        for (int ai = 0; ai < 2; ++ai)
#pragma unroll
            for (int m = 0; m < 4; ++m) { const int row = row0 + ai * HALF + m * 16; float s = 0.f;
#pragma unroll
                for (int bj = 0; bj < 2; ++bj) { const u32x4 r = rv[ai][m][bj];
                    const f32x4 r0 = {__uint_as_float(r.x << 16), __uint_as_float(r.x & 0xffff0000u), __uint_as_float(r.y << 16), __uint_as_float(r.y & 0xffff0000u)};
                    const f32x4 r1 = {__uint_as_float(r.z << 16), __uint_as_float(r.z & 0xffff0000u), __uint_as_float(r.w << 16), __uint_as_float(r.w & 0xffff0000u)};
                    const f32x4 o0 = r0 + acc[ai][bj][m][0] * alpha, o1 = r1 + acc[ai][bj][m][1] * alpha;
                    s += (o0[0] * o0[0] + o0[1] * o0[1]) + (o0[2] * o0[2] + o0[3] * o0[3]) + (o1[0] * o1[0] + o1[1] * o1[1]) + (o1[2] * o1[2] + o1[3] * o1[3]);
                    u32x4 w; w.x = cvt_pk_bf16(o0[0], o0[1]); w.y = cvt_pk_bf16(o0[2], o0[3]); w.z = cvt_pk_bf16(o1[0], o1[1]); w.w = cvt_pk_bf16(o1[2], o1[3]);
                    *(u32x4*)(xb + (size_t)row * D + col0 + bj * HALF) = w; }
                if (ss) { s = sum_fq(s); if (fq == 0) atomicAdd(ss + row, s); } }
        asm volatile("" ::: "memory");
    }
};
template <bool RES_BF16, bool OUT_F32, bool OUT_BF16> struct EpiRes {
    static constexpr bool PRE = false, PERM = false, FOLD = false, EPI_TWICE = false, EPI_DRY = false;
    static constexpr int TOUCH = 0;
    static constexpr int NB = RES_BF16 ? 1 : 2;
    const float* resf; const bf16_t* resb; float* out; bf16_t* xb; float* ss; float alpha;
    __device__ __forceinline__ void operator()(const f32x4 (&acc)[2][2][4][2], const Unit& u, int wr, int wc, int fr, int fq) const {
        const int row0 = u.pm * BM + wr * 64 + fr, col0 = u.pn * BM + wc * 32 + 4 * fq;
#pragma unroll
        for (int bt = 0; bt < NB; ++bt) {
            f32x4 rvf[RES_BF16 ? 1 : 1][RES_BF16 ? 1 : 4][2][2]; u32x2 rvb[RES_BF16 ? 2 : 1][RES_BF16 ? 4 : 1][2][2];
#pragma unroll
            for (int a2 = 0; a2 < 2 / NB; ++a2)
#pragma unroll
                for (int m = 0; m < 4; ++m) { const int ai = bt * (2 / NB) + a2; const size_t off = (size_t)(row0 + ai * HALF + m * 16) * D + col0;
#pragma unroll
                    for (int bj = 0; bj < 2; ++bj)
#pragma unroll
                        for (int n = 0; n < 2; ++n) { if (RES_BF16) rvb[a2][m][bj][n] = *(const u32x2*)(resb + off + bj * HALF + n * 16); else rvf[0][m][bj][n] = *(const f32x4*)(resf + off + bj * HALF + n * 16); } }
            asm volatile("" ::: "memory");
#pragma unroll
            for (int a2 = 0; a2 < 2 / NB; ++a2)
#pragma unroll
                for (int m = 0; m < 4; ++m) { const int ai = bt * (2 / NB) + a2, row = row0 + ai * HALF + m * 16; const size_t off = (size_t)row * D + col0; float s = 0.f;
#pragma unroll
                    for (int bj = 0; bj < 2; ++bj)
#pragma unroll
                        for (int n = 0; n < 2; ++n) {
                            f32x4 rv;
                            if (RES_BF16) { const u32x2 w = rvb[a2][m][bj][n]; rv = (f32x4){__uint_as_float(w.x << 16), __uint_as_float(w.x & 0xffff0000u), __uint_as_float(w.y << 16), __uint_as_float(w.y & 0xffff0000u)}; }
                            else rv = rvf[0][m][bj][n];
                            const f32x4 o = rv + acc[ai][bj][m][n] * alpha;
                            if (OUT_F32) *(f32x4*)(out + off + bj * HALF + n * 16) = o;
                            s += (o[0] * o[0] + o[1] * o[1]) + (o[2] * o[2] + o[3] * o[3]);
                            if (OUT_BF16) { u32x2 w; w.x = cvt_pk_bf16(o[0], o[1]); w.y = cvt_pk_bf16(o[2], o[3]); *(u32x2*)(xb + off + bj * HALF + n * 16) = w; } }
                    if (ss) { s = sum_fq(s); if (fq == 0) atomicAdd(ss + row, s); } }
            asm volatile("" ::: "memory"); }
    }
};
struct EpiWin {
    static constexpr bool PERM = true, FOLD = false, EPI_TWICE = false, EPI_DRY = false; static constexpr int TOUCH = 0;
    bf16_t* QKV; unsigned char* G; const float* ss1; const float *gq, *gk, *gxq; bf16_t* dry; bf16_t* drybase;
    static constexpr bool PRE = true;
    __device__ __forceinline__ RowPre pre(const Unit& u, int wr, int fr) const { RowPre q; const int row0 = u.pm * BM + wr * 64 + fr;
#pragma unroll
        for (int ai = 0; ai < 2; ++ai)
#pragma unroll
            for (int m = 0; m < 4; ++m) q.r[ai][m] = ss1[row0 + ai * HALF + m * 16];
        return q; }
    __device__ __forceinline__ void operator()(const f32x4 (&acc)[2][2][4][2], const Unit& u, int wr, int wc, int fr, int fq, const RowPre& q) const {
        const int row0 = u.pm * BM + wr * 64 + fr;
        if (u.pn >= 10) {
            const int col0 = (u.pn - 10) * BM + wc * 64 + 16 * fq;
#pragma unroll
            for (int ai = 0; ai < 2; ++ai)
#pragma unroll
                for (int m = 0; m < 4; ++m) { const int row = row0 + ai * HALF + m * 16; const float r = __builtin_amdgcn_rsqf(q.r[ai][m] * (1.0f / D) + EPS); u32x4 w;
                    w.x = gate_q4(acc[ai][0][m][0] * r); w.y = gate_q4(acc[ai][0][m][1] * r); w.z = gate_q4(acc[ai][1][m][0] * r); w.w = gate_q4(acc[ai][1][m][1] * r);
                    store16_wt((void*)(G + (size_t)row * NGATE + col0), w); }
            return;
        }
        const int head = 4 * u.pn + wc;
        const bool norm = (head >= 18 && head < 30) || head >= 36;
        const float* gain = (head >= 18 && head < 24) ? gq : (head >= 24 && head < 30) ? gk : (head >= 36) ? gxq : nullptr;
        const float cs = (head < 6 || (head >= 18 && head < 24) || head >= 36) ? QSCALE : 1.0f;
        f32x4 mul[2][2];
#pragma unroll
        for (int bj = 0; bj < 2; ++bj)
#pragma unroll
            for (int n = 0; n < 2; ++n) { f32x4 g = {1.f, 1.f, 1.f, 1.f}; if (gain) g = *(const f32x4*)(gain + 32 * bj + 8 * fq + 4 * n); mul[bj][n] = g * cs; }
#pragma unroll
        for (int ai = 0; ai < 2; ++ai)
#pragma unroll
            for (int m = 0; m < 4; ++m) { const int row = row0 + ai * HALF + m * 16; const float r = __builtin_amdgcn_rsqf(q.r[ai][m] * (1.0f / D) + EPS); f32x4 v[2][2]; float s = 0.f;
#pragma unroll
                for (int bj = 0; bj < 2; ++bj)
#pragma unroll
                    for (int n = 0; n < 2; ++n) { v[bj][n] = acc[ai][bj][m][n] * r; const f32x4 t = v[bj][n]; s += (t[0] * t[0] + t[1] * t[1]) + (t[2] * t[2] + t[3] * t[3]); }
                float hr = 1.0f;
                if (norm) { s = sum_fq(s); hr = __builtin_amdgcn_rsqf(s * (1.0f / HD) + EPS); }
#pragma unroll
                for (int bj = 0; bj < 2; ++bj) { const f32x4 v0 = v[bj][0] * mul[bj][0] * hr, v1 = v[bj][1] * mul[bj][1] * hr; u32x4 w;
                    w.x = cvt_pk_bf16(v0[0], v0[1]); w.y = cvt_pk_bf16(v0[2], v0[3]); w.z = cvt_pk_bf16(v1[0], v1[1]); w.w = cvt_pk_bf16(v1[2], v1[3]);
                    store16_wt((void*)(QKV + ((size_t)head * M + row) * 64 + bj * 32 + 8 * fq), w); } }
    }
};
template <int STEP> struct EpiBranch {
    static constexpr bool PRE = false, PERM = true, FOLD = false, EPI_TWICE = false, EPI_DRY = false; static constexpr int TOUCH = 0;
    static constexpr int NB = STEP > 0 ? 2 : 1;
    const unsigned char* G; bf16_t* macc; bf16_t* merged;
    static __device__ __forceinline__ void up8(f32x4& lo, f32x4& hi, u32x4 w) {
        lo = (f32x4){__uint_as_float(w.x << 16), __uint_as_float(w.x & 0xffff0000u), __uint_as_float(w.y << 16), __uint_as_float(w.y & 0xffff0000u)};
        hi = (f32x4){__uint_as_float(w.z << 16), __uint_as_float(w.z & 0xffff0000u), __uint_as_float(w.w << 16), __uint_as_float(w.w & 0xffff0000u)}; }
    __device__ __forceinline__ void operator()(const f32x4 (&acc)[2][2][4][2], const Unit& u, int wr, int wc, int fr, int fq) const {
        const int row0 = u.pm * BM + wr * 64 + fr, col0 = u.pn * BM + wc * 32 + 8 * fq;
#pragma unroll
        for (int bt = 0; bt < NB; ++bt) {
            u32x2 gw[2 / NB][4][2]; u32x4 mw[1][STEP > 0 ? 4 : 1][2];
#pragma unroll
            for (int a2 = 0; a2 < 2 / NB; ++a2)
#pragma unroll
                for (int m = 0; m < 4; ++m) { const int ai = bt * (2 / NB) + a2, row = row0 + ai * HALF + m * 16;
#pragma unroll
                    for (int bj = 0; bj < 2; ++bj) { const int col = col0 + bj * HALF; gw[a2][m][bj] = *(const u32x2*)(G + (size_t)row * NGATE + col + STEP * D);
                        if (STEP > 0) mw[0][m][bj] = *(const u32x4*)(macc + (size_t)row * D + col); } }
            asm volatile("" ::: "memory");
#pragma unroll
            for (int a2 = 0; a2 < 2 / NB; ++a2)
#pragma unroll
                for (int m = 0; m < 4; ++m) { const int ai = bt * (2 / NB) + a2, row = row0 + ai * HALF + m * 16;
#pragma unroll
                    for (int bj = 0; bj < 2; ++bj) { const int col = col0 + bj * HALF;
                        f32x4 g0 = gate_dq4(gw[a2][m][bj].x), g1 = gate_dq4(gw[a2][m][bj].y);
#pragma unroll
                        for (int i = 0; i < 4; ++i) { g0[i] = fast_sigmoid(g0[i]); g1[i] = fast_sigmoid(g1[i]); }
                        f32x4 v0 = g0 * acc[ai][bj][m][0], v1 = g1 * acc[ai][bj][m][1];
                        if (STEP > 0) { f32x4 m0, m1; up8(m0, m1, mw[0][m][bj]); v0 += m0; v1 += m1; }
                        u32x4 w; w.x = cvt_pk_bf16(v0[0], v0[1]); w.y = cvt_pk_bf16(v0[2], v0[3]); w.z = cvt_pk_bf16(v1[0], v1[1]); w.w = cvt_pk_bf16(v1[2], v1[3]);
                        *(u32x4*)((STEP < 2 ? macc : merged) + (size_t)row * D + col) = w; } }
            asm volatile("" ::: "memory"); }
    }
};

struct EpiBranchChain {
    static constexpr bool PRE = false, PERM = true, FOLD = false, EPI_TWICE = false, EPI_DRY = false; static constexpr int TOUCH = 0;
    const unsigned char* G; bf16_t* macc; bf16_t* merged;
    struct Q { u32x2 g[2][2]; u32x4 m[2][2]; };
    __device__ __forceinline__ void operator()(const f32x4 (&acc)[2][2][4][2], const Unit& u, int wr, int wc, int fr, int fq) const {
        const int row0 = u.pm * BM + wr * 64 + fr, col0 = u.pn * BM + wc * 32 + 8 * fq, step = u.step;
        const unsigned char* gb = G + step * D; bf16_t* dst = step < 2 ? macc : merged;
        auto load = [&](Q& s, const int q) __attribute__((always_inline)) {
#pragma unroll
            for (int mm = 0; mm < 2; ++mm) { const int row = row0 + (q >> 1) * HALF + (2 * (q & 1) + mm) * 16;
#pragma unroll
                for (int bj = 0; bj < 2; ++bj) { s.g[mm][bj] = *(const u32x2*)(gb + (size_t)row * NGATE + col0 + bj * HALF); s.m[mm][bj] = (u32x4){0u, 0u, 0u, 0u}; } }
            if (step > 0) {
#pragma unroll
                for (int mm = 0; mm < 2; ++mm)
#pragma unroll
                    for (int bj = 0; bj < 2; ++bj) s.m[mm][bj] = *(const u32x4*)(macc + (size_t)(row0 + (q >> 1) * HALF + (2 * (q & 1) + mm) * 16) * D + col0 + bj * HALF); }
        };
        auto work = [&](const Q& s, const int q) __attribute__((always_inline)) {
#pragma unroll
            for (int mm = 0; mm < 2; ++mm) { const int ai = q >> 1, m = 2 * (q & 1) + mm, row = row0 + ai * HALF + m * 16;
#pragma unroll
                for (int bj = 0; bj < 2; ++bj) { const int col = col0 + bj * HALF;
                    f32x4 g0 = gate_dq4(s.g[mm][bj].x), g1 = gate_dq4(s.g[mm][bj].y), m0, m1;
#pragma unroll
                    for (int i = 0; i < 4; ++i) { g0[i] = fast_sigmoid(g0[i]); g1[i] = fast_sigmoid(g1[i]); }
                    EpiBranch<1>::up8(m0, m1, s.m[mm][bj]);
                    const f32x4 v0 = g0 * acc[ai][bj][m][0] + m0, v1 = g1 * acc[ai][bj][m][1] + m1;
                    u32x4 w; w.x = cvt_pk_bf16(v0[0], v0[1]); w.y = cvt_pk_bf16(v0[2], v0[3]); w.z = cvt_pk_bf16(v1[0], v1[1]); w.w = cvt_pk_bf16(v1[2], v1[3]);
                    *(u32x4*)(dst + (size_t)row * D + col) = w; } }
        };
        Q sa, sb;
        load(sa, 0); load(sb, 1); asm volatile("" ::: "memory");
        work(sa, 0); asm volatile("" ::: "memory"); load(sa, 2); asm volatile("" ::: "memory");
        work(sb, 1); asm volatile("" ::: "memory"); load(sb, 3); asm volatile("" ::: "memory");
        work(sa, 2); asm volatile("" ::: "memory");
        work(sb, 3); asm volatile("" ::: "memory");
    }
};

template <class Epi, class Sched>
__device__ __forceinline__ void gemm_phase(PG8_LAS unsigned char* lds, const Gemm g, const Sched& S, const Epi& E, const int wid  ) {
    int lane; asm volatile("v_mbcnt_lo_u32_b32 %0, -1, 0\n\tv_mbcnt_hi_u32_b32 %0, -1, %0" : "=v"(lane));
    const int tid = wid * 64 + lane, wr = wid >> 2, wc = wid & 3, fr = lane & 15, fq = lane >> 4;
    const int ldb = g.ldb, lda = g.lda; int nt = g.K / BK;
    unsigned voffA[2], voffB[2];
#pragma unroll
    for (int i = 0; i < 2; ++i) { int R, C; stage_rc(tid * 16 + i * 8192, R, C); const int Rb = Epi::PERM ? ((R & ~31) + perm32(R & 31)) : R;
        voffA[i] = (unsigned)(R * lda + C) * 2u; voffB[i] = (unsigned)(Rb * ldb + C) * 2u; }
    const size_t kstep = (size_t)(BK * 2);
    const size_t hsA = (size_t)HALF * lda * 2, hsB = (size_t)HALF * ldb * 2;
    const size_t tsA = 2 * hsA, tsB = 2 * hsB;
    const unsigned ldsw = (unsigned)wid * 1024u;
    const int aoff = lds_byte(wr * 64 + fr, fq * 8), boff = lds_byte(wc * 32 + fr, fq * 8);
#define PG8_SA(b, h) (((b) * 2 + (h)) * HTB)
#define PG8_SB(b, h) ((4 + (b) * 2 + (h)) * HTB)
#define PG8_STAGE(bufoff, gbase, voff) do { _Pragma("unroll") for (int _i = 0; _i < 2; ++_i) \
        __builtin_amdgcn_global_load_lds((const unsigned*)((const char*)(gbase) + (voff)[_i]), (PG8_LAS unsigned*)(lds + (bufoff) + ldsw + _i * 8192), 16, 0, 0); } while (0)
    PG8_LAS const unsigned char* ldsA = lds + aoff; PG8_LAS const unsigned char* ldsB = lds + 4 * HTB + boff;
    asm volatile("" : "+v"(ldsA), "+v"(ldsB));
#define PG8_LDA(dst, b, h) do { _Pragma("unroll") for (int m = 0; m < 4; ++m) _Pragma("unroll") for (int k = 0; k < 2; ++k) dst[m][k] = *(const PG8_LAS bf16x8*)(ldsA + ((b) * 2 + (h)) * HTB + m * 2048 + k * 1024); } while (0)
#define PG8_LDB(dst, b, h) do { _Pragma("unroll") for (int n = 0; n < 2; ++n) _Pragma("unroll") for (int k = 0; k < 2; ++k) dst[n][k] = *(const PG8_LAS bf16x8*)(ldsB + ((b) * 2 + (h)) * HTB + n * 2048 + k * 1024); } while (0)
#define PG8_MMA(ai, bj, At, Bt) do { __builtin_amdgcn_s_setprio(1); _Pragma("unroll") for (int m = 0; m < 4; ++m) _Pragma("unroll") for (int n = 0; n < 2; ++n) _Pragma("unroll") for (int k = 0; k < 2; ++k) \
        acc[ai][bj][m][n] = __builtin_amdgcn_mfma_f32_16x16x32_bf16(Bt[n][k], At[m][k], acc[ai][bj][m][n], 0, 0, 0); __builtin_amdgcn_s_setprio(0); } while (0)
#define PG8_WAIT_V(n) asm volatile("s_waitcnt vmcnt(" #n ")" ::: "memory")
#define PG8_WAIT_L(n) asm volatile("s_waitcnt lgkmcnt(" #n ")" ::: "memory")
#define PG8_BAR __builtin_amdgcn_s_barrier()
#define PG8_SCHED __builtin_amdgcn_sched_barrier(0)
#if !PG8_USE_SP2
#define PG8_KTILE2(t) do { \
            const bool last = (t == nt - 2); \
            const char* a1 = cA + (size_t)(t + 1) * kstep; \
            const char* a2 = last ? nA : cA + (size_t)(t + 2) * kstep; const char* b2 = last ? nB : cB + (size_t)(t + 2) * kstep; \
            const char* a3 = a2 + kstep; const char* b3 = b2 + kstep; \
            PG8_LDB(B0, 0, 0); PG8_SCHED; PG8_LDA(At, 0, 0); PG8_STAGE(PG8_SA(1, 1), a1 + hsA, voffA); \
            PG8_WAIT_L(8); PG8_BAR; PG8_WAIT_L(0); PG8_MMA(0, 0, At, B0); PG8_BAR; PG8_SCHED; \
            PG8_LDB(B1, 0, 1); PG8_STAGE(PG8_SB(0, 0), b2, voffB); \
            PG8_BAR; PG8_WAIT_L(0); PG8_MMA(0, 1, At, B1); PG8_BAR; \
            PG8_LDA(At, 0, 1); PG8_STAGE(PG8_SA(0, 0), a2, voffA); \
            PG8_BAR; PG8_WAIT_L(0); PG8_MMA(1, 0, At, B0); PG8_BAR; PG8_SCHED; \
            PG8_STAGE(PG8_SB(0, 1), b2 + hsB, voffB); \
            PG8_WAIT_V(6); PG8_BAR; PG8_MMA(1, 1, At, B1); PG8_BAR; \
            PG8_LDB(B0, 1, 0); PG8_SCHED; PG8_LDA(At, 1, 0); PG8_STAGE(PG8_SA(0, 1), a2 + hsA, voffA); \
            PG8_WAIT_L(8); PG8_BAR; PG8_WAIT_L(0); PG8_MMA(0, 0, At, B0); PG8_BAR; PG8_SCHED; \
            PG8_LDB(B1, 1, 1); PG8_STAGE(PG8_SB(1, 0), b3, voffB); \
            PG8_BAR; PG8_WAIT_L(0); PG8_MMA(0, 1, At, B1); PG8_BAR; \
            PG8_LDA(At, 1, 1); PG8_STAGE(PG8_SA(1, 0), a3, voffA); \
            PG8_BAR; PG8_WAIT_L(0); PG8_MMA(1, 0, At, B0); PG8_BAR; PG8_SCHED; \
            PG8_STAGE(PG8_SB(1, 1), b3 + hsB, voffB); \
            PG8_WAIT_V(6); PG8_BAR; PG8_MMA(1, 1, At, B1); PG8_BAR; \
        } while (0)
#else
#define PG8_KTILE2(t) do { \
            const bool last = (t == nt - 2); \
            const char* a1 = cA + (size_t)(t + 1) * kstep; \
            const char* a2 = last ? nA : cA + (size_t)(t + 2) * kstep; const char* b2 = last ? nB : cB + (size_t)(t + 2) * kstep; \
            const char* a3 = a2 + kstep; const char* b3 = b2 + kstep; \
            PG8_LDB(B0, 0, 0); PG8_LDB(B1, 0, 1); PG8_SCHED; PG8_LDA(At, 0, 0); PG8_STAGE(PG8_SA(1, 1), a1 + hsA, voffA); \
            PG8_WAIT_V(8); PG8_WAIT_L(0); PG8_BAR; PG8_MMA(0, 0, At, B0); PG8_MMA(0, 1, At, B1); PG8_BAR; PG8_SCHED; \
            PG8_LDA(At, 0, 1); PG8_STAGE(PG8_SB(0, 0), b2, voffB); PG8_STAGE(PG8_SB(0, 1), b2 + hsB, voffB); PG8_STAGE(PG8_SA(0, 0), a2, voffA); \
            PG8_WAIT_V(8); PG8_WAIT_L(0); PG8_BAR; PG8_MMA(1, 0, At, B0); PG8_MMA(1, 1, At, B1); PG8_BAR; PG8_SCHED; \
            PG8_LDB(B0, 1, 0); PG8_LDB(B1, 1, 1); PG8_SCHED; PG8_LDA(At, 1, 0); PG8_STAGE(PG8_SA(0, 1), a2 + hsA, voffA); \
            PG8_WAIT_V(8); PG8_WAIT_L(0); PG8_BAR; PG8_MMA(0, 0, At, B0); PG8_MMA(0, 1, At, B1); PG8_BAR; PG8_SCHED; \
            PG8_LDA(At, 1, 1); PG8_STAGE(PG8_SB(1, 0), b3, voffB); PG8_STAGE(PG8_SB(1, 1), b3 + hsB, voffB); PG8_STAGE(PG8_SA(1, 0), a3, voffA); \
            PG8_WAIT_V(8); PG8_WAIT_L(0); PG8_BAR; PG8_MMA(1, 0, At, B0); PG8_MMA(1, 1, At, B1); PG8_BAR; PG8_SCHED; \
        } while (0)
#endif
    Unit cur, nxt; int ui = 0;
    if (!S.next(0, cur)) return;
    f32x4 acc[2][2][4][2];
#pragma unroll
    for (int a = 0; a < 2; ++a)
#pragma unroll
        for (int b = 0; b < 2; ++b)
#pragma unroll
            for (int m = 0; m < 4; ++m)
#pragma unroll
                for (int n = 0; n < 2; ++n) acc[a][b][m][n] = (f32x4){0.f, 0.f, 0.f, 0.f};
    bf16x8 At[4][2], B0[2][2], B1[2][2];
    const char* cA = (const char*)g.A + (size_t)cur.pm * tsA + (size_t)cur.koff * 2; const char* cB = (const char*)g.Bt + (size_t)cur.pn * tsB + (size_t)cur.koff * 2;
    if (cur.ntu) nt = cur.ntu;
#if PG8_USE_SP2
    PG8_STAGE(PG8_SB(0, 0), cB, voffB); PG8_STAGE(PG8_SB(0, 1), cB + hsB, voffB); PG8_STAGE(PG8_SA(0, 0), cA, voffA); PG8_STAGE(PG8_SA(0, 1), cA + hsA, voffA);
    if (wr == 1) PG8_BAR;
    PG8_WAIT_V(2); PG8_BAR;
#else
    PG8_STAGE(PG8_SB(0, 0), cB, voffB); PG8_STAGE(PG8_SA(0, 0), cA, voffA); PG8_STAGE(PG8_SB(0, 1), cB + hsB, voffB); PG8_STAGE(PG8_SA(0, 1), cA + hsA, voffA);
    if (wr == 1) PG8_BAR;
    PG8_WAIT_V(4); PG8_BAR;
#endif
    PG8_STAGE(PG8_SB(1, 0), cB + kstep, voffB); PG8_STAGE(PG8_SA(1, 0), cA + kstep, voffA); PG8_STAGE(PG8_SB(1, 1), cB + hsB + kstep, voffB);
    PG8_WAIT_V(6); PG8_BAR;
    for (;;) {
        RowPre rowpre; if constexpr (Epi::PRE) rowpre = E.pre(cur, wr, fr);
        const bool has_next = S.next(ui + 1, nxt);
        const char* nA = has_next ? (const char*)g.A + (size_t)nxt.pm * tsA + (size_t)nxt.koff * 2 : cA; const char* nB = has_next ? (const char*)g.Bt + (size_t)nxt.pn * tsB + (size_t)nxt.koff * 2 : cB;
        if constexpr (Epi::FOLD) {
            static_assert(Epi::NT == 12 && Epi::F1 == 6 && Epi::F2 == 8, "the fold walk below is written out for K = 384 | 128 | 256");
            PG8_KTILE2(0); PG8_KTILE2(2); PG8_KTILE2(4);
            PG8_SCHED; E.fold(acc, cur, 0, wr, wc, fr, fq); PG8_SCHED;
            PG8_KTILE2(6);
            PG8_SCHED; E.fold(acc, cur, 1, wr, wc, fr, fq); PG8_SCHED;
            PG8_KTILE2(8); PG8_KTILE2(10);
        } else {
            for (int t = 0; t < nt; t += 2) { if constexpr (Epi::TOUCH > 0) { if (t < 2 * Epi::TOUCH) E.touch(cur, t >> 1, wid, lane, lds); } PG8_KTILE2(t); }
        }
        if (wr == 0) PG8_BAR;
        if constexpr (Epi::PRE) E(acc, cur, wr, wc, fr, fq, rowpre); else E(acc, cur, wr, wc, fr, fq);
        if (!has_next) break;
#pragma unroll
        for (int a = 0; a < 2; ++a)
#pragma unroll
            for (int b = 0; b < 2; ++b)
#pragma unroll
                for (int m = 0; m < 4; ++m)
#pragma unroll
                    for (int n = 0; n < 2; ++n) acc[a][b][m][n] = (f32x4){0.f, 0.f, 0.f, 0.f};
        cur = nxt; cA = nA; cB = nB; ++ui; if (cur.ntu) nt = cur.ntu;
        if (wr == 1) PG8_BAR;
    }
    PG8_WAIT_V(0);
    PG8_BAR;
#undef PG8_SA
#undef PG8_SB
#undef PG8_STAGE
#undef PG8_LDA
#undef PG8_LDB
#undef PG8_MMA
#undef PG8_WAIT_V
#undef PG8_WAIT_L
#undef PG8_BAR
#undef PG8_SCHED
#undef PG8_KTILE2
}
}

namespace att {
#define ATT_LAS __attribute__((address_space(3)))
typedef short bf16x8 __attribute__((ext_vector_type(8)));
typedef short s16x4 __attribute__((ext_vector_type(4)));
typedef float f32x16 __attribute__((ext_vector_type(16)));
typedef unsigned u32x2 __attribute__((ext_vector_type(2)));
typedef unsigned u32x4 __attribute__((ext_vector_type(4)));
constexpr int KSTRIDE = 144, KSTAGE = 32 * KSTRIDE;
constexpr int VSTRIDE = 192, VSTAGE = 32 * VSTRIDE;
constexpr int WSTAGE = KSTAGE + VSTAGE;
constexpr int TBLN = 132;
constexpr int LDS_TBL = 0, LDS_VST = 4096, LDS_BYTES = LDS_VST + 8 * WSTAGE;
constexpr float NEG = -1e30f;
__device__ __forceinline__ int crow(int r, int hi) { return (r & 3) + 8 * (r >> 2) + 4 * hi; }
typedef float f32x2_t __attribute__((ext_vector_type(2))); typedef __bf16 bf16x2_t __attribute__((ext_vector_type(2)));
__device__ __forceinline__ unsigned cvtpk(float lo, float hi) { const f32x2_t v = {lo, hi}; return __builtin_bit_cast(unsigned, __builtin_convertvector(v, bf16x2_t)); }

__device__ __forceinline__ void load_frag4(bf16x8 (&f)[4], const bf16_t* rowp, int hi) {
#pragma unroll
    for (int d0 = 0; d0 < 4; ++d0) f[d0] = *(const bf16x8*)(rowp + d0 * 16 + hi * 8);
}
__device__ __forceinline__ f32x16 qk_tile(const bf16x8 (&kf)[4], const bf16x8 (&qf)[4]) {
    f32x16 s = {0.f, 0.f, 0.f, 0.f, 0.f, 0.f, 0.f, 0.f, 0.f, 0.f, 0.f, 0.f, 0.f, 0.f, 0.f, 0.f};
#pragma unroll
    for (int d0 = 0; d0 < 4; ++d0) s = __builtin_amdgcn_mfma_f32_32x32x16_bf16(kf[d0], qf[d0], s, 0, 0, 0);
    return s;
}
struct TileRegs { u32x4 k[4], v[4]; };
template <class KRow, class VRow> __device__ __forceinline__ void load_tile(TileRegs& t, KRow krow, VRow vrow, int lane) {
#pragma unroll
    for (int j = 0; j < 4; ++j) { const int r = 8 * j + (lane >> 3); t.k[j] = *(const u32x4*)(krow(r) + (lane & 7) * 8); t.v[j] = *(const u32x4*)(vrow(r) + (lane & 7) * 8); }
}
__device__ __forceinline__ void stage_tile(ATT_LAS unsigned char* st, const TileRegs& t, int lane) {
#pragma unroll
    for (int j = 0; j < 4; ++j) { const int r = 8 * j + (lane >> 3);
        *(ATT_LAS u32x4*)(st + r * KSTRIDE + (lane & 7) * 16) = t.k[j]; *(ATT_LAS u32x4*)(st + KSTAGE + r * VSTRIDE + (lane & 7) * 16) = t.v[j]; }
}
__device__ __forceinline__ void read_kfrag(bf16x8 (&kf)[4], ATT_LAS const unsigned char* st, int lane) {
    ATT_LAS const unsigned char* p = st + (lane & 31) * KSTRIDE + (lane >> 5) * 16;
#pragma unroll
    for (int d0 = 0; d0 < 4; ++d0) kf[d0] = *(ATT_LAS const bf16x8*)(p + d0 * 32);
}
typedef short v4i16_t __attribute__((ext_vector_type(4)));
__device__ __forceinline__ s16x4 vtr(ATT_LAS const unsigned char* p) { return __builtin_bit_cast(s16x4, __builtin_amdgcn_ds_read_tr16_b64_v4i16((ATT_LAS v4i16_t*)p)); }
__device__ __forceinline__ void read_vfrag(bf16x8 (&vf)[2][2], ATT_LAS const unsigned char* vb) {
#pragma unroll
    for (int s = 0; s < 2; ++s)
#pragma unroll
        for (int d0 = 0; d0 < 2; ++d0) { const s16x4 lo = vtr(vb + (16 * s) * VSTRIDE + 64 * d0), hi = vtr(vb + (16 * s + 8) * VSTRIDE + 64 * d0);
            vf[s][d0] = (bf16x8){lo[0], lo[1], lo[2], lo[3], hi[0], hi[1], hi[2], hi[3]}; }
}
__device__ __forceinline__ void pv_mma(f32x16 (&o)[2], const bf16x8 (&vf)[2][2], const bf16x8 (&pw)[2]) {
#pragma unroll
    for (int s = 0; s < 2; ++s)
#pragma unroll
        for (int d0 = 0; d0 < 2; ++d0) o[d0] = __builtin_amdgcn_mfma_f32_32x32x16_bf16(vf[s][d0], pw[s], o[d0], 0, 0, 0);
}
__device__ __forceinline__ float swap32(float x) { const auto rr = __builtin_amdgcn_permlane32_swap(__float_as_uint(x), __float_as_uint(x), false, false); return __uint_as_float((__builtin_amdgcn_mbcnt_hi(~0u, __builtin_amdgcn_mbcnt_lo(~0u, 0u)) < 32u) ? rr[1] : rr[0]); }
__device__ __forceinline__ void pack_p(bf16x8 (&pw)[2], const f32x16& p) {
#pragma unroll
    for (int s = 0; s < 2; ++s) { u32x4 w; w.x = cvtpk(p[8 * s], p[8 * s + 1]); w.y = cvtpk(p[8 * s + 2], p[8 * s + 3]); w.z = cvtpk(p[8 * s + 4], p[8 * s + 5]); w.w = cvtpk(p[8 * s + 6], p[8 * s + 7]);
        pw[s] = __builtin_bit_cast(bf16x8, w); }
}
__device__ __forceinline__ void softmax_step(f32x16& p, float& m, float& zl, f32x16 (&o)[2]) {
    float tm = fmaxf(fmaxf(p[0], p[1]), fmaxf(p[2], p[3]));
#pragma unroll
    for (int r = 4; r < 16; r += 4) tm = fmaxf(tm, fmaxf(fmaxf(p[r], p[r + 1]), fmaxf(p[r + 2], p[r + 3])));
    { const auto rr = __builtin_amdgcn_permlane32_swap(__float_as_uint(tm), __float_as_uint(tm), false, false); tm = fmaxf(__uint_as_float(rr[0]), __uint_as_float(rr[1])); }
    if (__any(tm > m + 8.0f)) {
        const float mn = fmaxf(m, tm), al = __builtin_amdgcn_exp2f(m - mn); m = mn;
        zl *= al;
#pragma unroll
        for (int d0 = 0; d0 < 2; ++d0)
#pragma unroll
            for (int r = 0; r < 16; ++r) o[d0][r] *= al;
    }
    float s = 0.f;
#pragma unroll
    for (int r = 0; r < 16; ++r) { p[r] = __builtin_amdgcn_exp2f(p[r] - m); s += p[r]; }
    zl += s;
}
__device__ __forceinline__ void store_o(const f32x16 (&o)[2], float scale, bf16_t* orow, int hi) {
#pragma unroll
    for (int d0 = 0; d0 < 2; ++d0)
#pragma unroll
        for (int g = 0; g < 4; ++g) { u32x2 w; w.x = cvtpk(o[d0][4 * g] * scale, o[d0][4 * g + 1] * scale); w.y = cvtpk(o[d0][4 * g + 2] * scale, o[d0][4 * g + 3] * scale);
            *(u32x2*)(orow + 32 * d0 + 8 * g + 4 * hi) = w; }
}

template <bool DRY = false> __device__ __forceinline__ void sb_unit(int id, const bf16_t* QKV, bf16_t* OC, ATT_LAS unsigned char* vst, int lane) {
    asm volatile("" : "+v"(lane));
    const int bh = id >> 8, qt = id & 255, b = bh / 6, h = bh - 6 * b, t0 = qt * 32, i = lane & 31, hi = lane >> 5;
    const size_t HS = (size_t)M * 64;
    const bf16_t* base = QKV + (size_t)h * HS + (size_t)b * S * 64;
    bf16x8 qf[4]; load_frag4(qf, base + (size_t)(t0 + i) * 64, hi);
    f32x16 o[2];
#pragma unroll
    for (int r = 0; r < 16; ++r) { o[0][r] = 0.f; o[1][r] = 0.f; }
    ATT_LAS const unsigned char* vb = vst + KSTAGE + (4 * hi + ((lane & 15) >> 2)) * VSTRIDE + ((lane >> 4) & 1) * 32 + (lane & 3) * 8;
    float c = 0.f;
#define SB_LOAD(T_, k_) load_tile(T_, [&](int r) { return base + 6 * HS + (size_t)((k_) + r) * 64; }, [&](int r) { return base + 12 * HS + (size_t)((k_) + r) * 64; }, lane)
    auto tile = [&](const int k0, TileRegs& tr, const int knext) __attribute__((always_inline)) -> bool {
        asm volatile("s_waitcnt lgkmcnt(0)" ::: "memory");
        stage_tile(vst, tr, lane);
        if (knext >= 0 && !DRY) SB_LOAD(tr, knext);
        asm volatile("s_waitcnt lgkmcnt(0)" ::: "memory");
        bf16x8 kf[4], vf[2][2]; read_kfrag(kf, vst, lane); read_vfrag(vf, vb);
        f32x16 z = qk_tile(kf, qf);
        float w[16];
        const bool diag = (k0 == t0);
#pragma unroll
        for (int r = 0; r < 16; ++r) { const float zz = z[r], e = __builtin_amdgcn_exp2f(-fabsf(zz)), l2 = __builtin_amdgcn_logf(1.0f + e);
            w[r] = fmaxf(zz, 0.f) + l2; z[r] = fminf(zz, 0.f) - l2; }
        if (diag) { int ii = i - 4 * hi; asm volatile("" : "+v"(ii));
#pragma unroll
            for (int r = 0; r < 16; ++r) if (!((r & 3) + 8 * (r >> 2) < ii)) { w[r] = 0.f; z[r] = NEG; } }
        float a[16], T[4], Tp[4];
#pragma unroll
        for (int g = 0; g < 4; ++g) { a[4 * g + 3] = 0.f; a[4 * g + 2] = w[4 * g + 3]; a[4 * g + 1] = a[4 * g + 2] + w[4 * g + 2]; a[4 * g] = a[4 * g + 1] + w[4 * g + 1]; T[g] = a[4 * g] + w[4 * g]; }
#pragma unroll
        for (int g = 0; g < 4; ++g) { const auto rr = __builtin_amdgcn_permlane32_swap(__float_as_uint(T[g]), __float_as_uint(T[g]), false, false); Tp[g] = __uint_as_float(hi == 0 ? rr[1] : rr[0]); }
        const float p3 = T[3] + Tp[3], p2 = T[2] + Tp[2], p1 = T[1] + Tp[1], p0 = T[0] + Tp[0];
        float cum[4]; cum[3] = 0.f; cum[2] = p3; cum[1] = p3 + p2; cum[0] = cum[1] + p1; const float total = cum[0] + p0;
        f32x16 p;
#pragma unroll
        for (int g = 0; g < 4; ++g) { const float bg = c - cum[g] - (hi == 0 ? Tp[g] : 0.f);
#pragma unroll
            for (int j = 0; j < 4; ++j) p[4 * g + j] = __builtin_amdgcn_exp2f(z[4 * g + j] + (bg - a[4 * g + j])); }
        c -= total;
        bf16x8 pw[2]; pack_p(pw, p);
        pv_mma(o, vf, pw);
        return k0 < 32 || __all(c < -150.0f);
    };
    TileRegs ta, tb;
    SB_LOAD(ta, t0); if (t0 >= 32) SB_LOAD(tb, t0 - 32);
#pragma unroll 1
    for (int k0 = t0; ; k0 -= 64) {
        if (tile(k0, ta, k0 - 64)) break;
        if (tile(k0 - 32, tb, k0 - 96)) break;
    }
#undef SB_LOAD
    store_o(o, 1.0f, OC + (size_t)(DRY ? ((b * S + t0 + i) & 4095) : (b * S + t0 + i)) * NOC + h * 64, hi);
}

__device__ __forceinline__ void dil_tile(int T, int& g, int& kt) { if (T < 5) { g = 2; kt = T; } else if (T < 13) { g = 1; kt = T - 5; } else { g = 0; kt = T - 13; } }
template <bool DRY = false> __device__ __forceinline__ void dil_unit(int id, const bf16_t* QKV, bf16_t* OC, ATT_LAS const float* tbl, ATT_LAS unsigned char* vst, int lane) {
    asm volatile("" : "+v"(lane));
    const int b = id >> 9, hh = (id >> 8) & 1, blk = (id >> 4) & 15, res = id & 15, i = lane & 31, hi = lane >> 5;
    const int tb = 512 * blk + res, tq = tb + 16 * i;
    const size_t HS = (size_t)M * 64;
    const bf16_t* base = QKV + (size_t)b * S * 64;
    f32x16 o[2];
#pragma unroll
    for (int r = 0; r < 16; ++r) { o[0][r] = 0.f; o[1][r] = 0.f; }
    ATT_LAS const unsigned char* vb = vst + KSTAGE + (4 * hi + ((lane & 15) >> 2)) * VSTRIDE + ((lane >> 4) & 1) * 32 + (lane & 3) * 8;
    float m = NEG, zl = 0.f;
    bf16x8 qf[4];
#define DIL_LOAD(R_, T_) do { int g_, kt_; dil_tile((T_), g_, kt_); const int sh_ = 2 * g_, hd_ = 2 * g_ + hh, rg_ = tb & ((1 << sh_) - 1), Jt_ = (tb >> sh_) - 128 + 32 * kt_, Jm_ = (S >> sh_) - 1; \
        auto krow_ = [&](int r) { int J_ = Jt_ + r; J_ = J_ < 0 ? 0 : J_; J_ = J_ > Jm_ ? Jm_ : J_; return base + (size_t)(24 + hd_) * HS + (size_t)(rg_ + (J_ << sh_)) * 64; }; \
        load_tile(R_, krow_, [&](int r) { return krow_(r) + 6 * HS; }, lane); } while (0)
    int gprev = -1;
    auto tile = [&](const int T, TileRegs& tr) __attribute__((always_inline)) {
        int g, kt; dil_tile(T, g, kt);
        const int sh = 2 * g, sq = 16 >> sh, Jt0 = (tb >> sh) - 128 + 32 * kt;
        if (g != gprev) { load_frag4(qf, base + (size_t)(18 + 2 * g + hh) * HS + (size_t)tq * 64, hi); gprev = g; }
        const bool skip = Jt0 + 31 < 0;
        asm volatile("s_waitcnt lgkmcnt(0)" ::: "memory");
        if (!skip) stage_tile(vst, tr, lane);
        if (T + 2 < 33 && !DRY) DIL_LOAD(tr, T + 2);
        if (skip) return;
        ATT_LAS const float* tb_g = tbl + (g * 2 + hh) * TBLN + 1;
        asm volatile("s_waitcnt lgkmcnt(0)" ::: "memory");
        bf16x8 kf[4], vf[2][2]; read_kfrag(kf, vst, lane); read_vfrag(vf, vb);
        f32x16 p = qk_tile(kf, qf);
        const int tb0 = (int)(unsigned)(unsigned long long)(ATT_LAS const unsigned char*)tb_g, c4 = tb0 + 4 * (sq * i + 128 - 32 * kt - 4 * hi), lo4 = tb0 - 4, hi4 = tb0 + 4 * 129;
        float bvs[16];
#pragma unroll
        for (int r = 0; r < 16; ++r) { int a4 = c4 - 4 * ((r & 3) + 8 * (r >> 2)); a4 = a4 < lo4 ? lo4 : a4; a4 = a4 > hi4 ? hi4 : a4; bvs[r] = *(ATT_LAS const float*)(ATT_LAS const unsigned char*)(unsigned long long)(unsigned)a4; }
        if (Jt0 < 0) {
#pragma unroll
            for (int r = 0; r < 16; ++r) if (Jt0 + 4 * hi + (r & 3) + 8 * (r >> 2) < 0) bvs[r] = NEG; }
#pragma unroll
        for (int r = 0; r < 16; ++r) p[r] += bvs[r];
        softmax_step(p, m, zl, o);
        bf16x8 pw[2]; pack_p(pw, p);
        pv_mma(o, vf, pw);
    };
    TileRegs ta, tbq;
    DIL_LOAD(ta, 0); DIL_LOAD(tbq, 1);
#pragma unroll 1
    for (int T = 0; T < 33; T += 2) {
        tile(T, ta);
        if (T + 1 < 33) tile(T + 1, tbq);
    }
#undef DIL_LOAD
    float Z; { const auto rr = __builtin_amdgcn_permlane32_swap(__float_as_uint(zl), __float_as_uint(zl), false, false); Z = __uint_as_float(rr[0]) + __uint_as_float(rr[1]); }
    store_o(o, 1.0f / Z, OC + (size_t)(DRY ? ((b * S + tq) & 4095) : (b * S + tq)) * NOC + 384 + hh * 64, hi);
}

__device__ __forceinline__ void dilg_unit(int b, int hh, int g, int r, int jt, const bf16_t* QKV, bf16_t* PART, float* LSE, ATT_LAS const float* tbl, ATT_LAS unsigned char* vst, int lane) {
    asm volatile("" : "+v"(lane));
    const int i = lane & 31, hi = lane >> 5, sh = 2 * g, J0 = 32 * jt, Jm = (S >> sh) - 1;
    const size_t HS = (size_t)M * 64;
    const bf16_t* kbase = QKV + (size_t)(24 + 2 * g + hh) * HS + (size_t)b * S * 64;
    const int tq = r + ((J0 + i) << sh);
    bf16x8 qf[4]; load_frag4(qf, kbase - 6 * HS + (size_t)tq * 64, hi);
    f32x16 o[2];
#pragma unroll
    for (int q = 0; q < 16; ++q) { o[0][q] = 0.f; o[1][q] = 0.f; }
    ATT_LAS const unsigned char* vb = vst + KSTAGE + (4 * hi + ((lane & 15) >> 2)) * VSTRIDE + ((lane >> 4) & 1) * 32 + (lane & 3) * 8;
    ATT_LAS const float* tb_g = tbl + (g * 2 + hh) * TBLN + 1;
    const int tb0 = (int)(unsigned)(unsigned long long)(ATT_LAS const unsigned char*)tb_g, lo4 = tb0 - 4, hi4 = tb0 + 4 * 129;
    float m = NEG, zl = 0.f;
#define DG_LOAD(R_, kt_) do { const int Jt_ = J0 - 128 + 32 * (kt_); \
        auto krow_ = [&](int q) { int J_ = Jt_ + q; J_ = J_ < 0 ? 0 : J_; J_ = J_ > Jm ? Jm : J_; return kbase + (size_t)(r + (J_ << sh)) * 64; }; \
        load_tile(R_, krow_, [&](int q) { return krow_(q) + 6 * HS; }, lane); } while (0)
    auto tile = [&](const int kt, TileRegs& tr) __attribute__((always_inline)) {
        const int Jt0 = J0 - 128 + 32 * kt;
        const bool skip = Jt0 + 31 < 0;
        asm volatile("s_waitcnt lgkmcnt(0)" ::: "memory");
        if (!skip) stage_tile(vst, tr, lane);
        if (kt + 2 < 5) DG_LOAD(tr, kt + 2);
        if (skip) return;
        asm volatile("s_waitcnt lgkmcnt(0)" ::: "memory");
        bf16x8 kf[4], vf[2][2]; read_kfrag(kf, vst, lane); read_vfrag(vf, vb);
        f32x16 p = qk_tile(kf, qf);
        const int c4 = tb0 + 4 * (i + 128 - 32 * kt - 4 * hi);
        float bvs[16];
#pragma unroll
        for (int q = 0; q < 16; ++q) { int a4 = c4 - 4 * ((q & 3) + 8 * (q >> 2)); a4 = a4 < lo4 ? lo4 : a4; a4 = a4 > hi4 ? hi4 : a4; bvs[q] = *(ATT_LAS const float*)(ATT_LAS const unsigned char*)(unsigned long long)(unsigned)a4; }
        if (Jt0 < 0) {
#pragma unroll
            for (int q = 0; q < 16; ++q) if (Jt0 + 4 * hi + (q & 3) + 8 * (q >> 2) < 0) bvs[q] = NEG; }
#pragma unroll
        for (int q = 0; q < 16; ++q) p[q] += bvs[q];
        softmax_step(p, m, zl, o);
        bf16x8 pw[2]; pack_p(pw, p);
        pv_mma(o, vf, pw);
    };
    TileRegs ta, tbq;
    DG_LOAD(ta, 0); DG_LOAD(tbq, 1);
    tile(0, ta); tile(1, tbq); tile(2, ta); tile(3, tbq); tile(4, ta);
#undef DG_LOAD
    float Z; { const auto rr = __builtin_amdgcn_permlane32_swap(__float_as_uint(zl), __float_as_uint(zl), false, false); Z = __uint_as_float(rr[0]) + __uint_as_float(rr[1]); }
    const size_t row = (size_t)b * S + tq;
    store_o(o, 1.0f / Z, PART + ((size_t)g * M + row) * 128 + hh * 64, hi);
    if (hi == 0) LSE[((size_t)g * M + row) * 2 + hh] = m + __builtin_amdgcn_logf(Z);
}
__device__ __forceinline__ void dil_combine(int b, int hh, int t0, int ntok, const bf16_t* PART, const float* LSE, bf16_t* OC, int lane) {
#pragma unroll 2
    for (int k = 0; k < ntok; k += 8) { const size_t row = (size_t)b * S + t0 + k + (lane >> 3);
        float l[3]; u32x4 pv[3];
#pragma unroll
        for (int g = 0; g < 3; ++g) { l[g] = LSE[((size_t)g * M + row) * 2 + hh]; pv[g] = *(const u32x4*)(PART + ((size_t)g * M + row) * 128 + hh * 64 + (lane & 7) * 8); }
        const float mx = fmaxf(fmaxf(l[0], l[1]), l[2]); float w[3], ws = 0.f;
#pragma unroll
        for (int g = 0; g < 3; ++g) { w[g] = __builtin_amdgcn_exp2f(l[g] - mx); ws += w[g]; }
        const float rz = __builtin_amdgcn_rcpf(ws); float acc[8];
#pragma unroll
        for (int e = 0; e < 8; ++e) acc[e] = 0.f;
#pragma unroll
        for (int g = 0; g < 3; ++g) { const float wg = w[g] * rz; const unsigned d4[4] = {pv[g].x, pv[g].y, pv[g].z, pv[g].w};
#pragma unroll
            for (int e = 0; e < 4; ++e) { acc[2 * e] += wg * __uint_as_float(d4[e] << 16); acc[2 * e + 1] += wg * __uint_as_float(d4[e] & 0xffff0000u); } }
        u32x4 o; o.x = cvtpk(acc[0], acc[1]); o.y = cvtpk(acc[2], acc[3]); o.z = cvtpk(acc[4], acc[5]); o.w = cvtpk(acc[6], acc[7]);
        *(u32x4*)(OC + row * NOC + 384 + hh * 64 + (lane & 7) * 8) = o; }
}

__device__ __forceinline__ void mem_unit(int id, const bf16_t* QKV, const bf16_t* MK, const bf16_t* MV, bf16_t* OC, ATT_LAS unsigned char* vst, int lane) {
    asm volatile("" : "+v"(lane));
    const int b = id >> 10, head = (id >> 8) & 3, qt = id & 255, t0 = qt * 32, i = lane & 31, hi = lane >> 5;
    bf16x8 qf[4]; load_frag4(qf, QKV + ((size_t)(36 + head) * M + (b * S + t0 + i)) * 64, hi);
    f32x16 o[2];
#pragma unroll
    for (int r = 0; r < 16; ++r) { o[0][r] = 0.f; o[1][r] = 0.f; }
    ATT_LAS const unsigned char* vb = vst + KSTAGE + (4 * hi + ((lane & 15) >> 2)) * VSTRIDE + ((lane >> 4) & 1) * 32 + (lane & 3) * 8;
    float m = NEG, zl = 0.f;
    const bf16_t* kb = MK + (size_t)(b * NMEM) * 256 + head * 64; const bf16_t* vbs = MV + (size_t)(b * NMEM) * 256 + head * 64;
    TileRegs tn;
    load_tile(tn, [&](int r) { return kb + (size_t)r * 256; }, [&](int r) { return vbs + (size_t)r * 256; }, lane);
#pragma unroll 1
    for (int kt = 0; kt < 8; ++kt) {
        const TileRegs tc = tn;
        if (kt + 1 < 8) { const int mn = 32 * (kt + 1); load_tile(tn, [&](int r) { return kb + (size_t)(mn + r) * 256; }, [&](int r) { return vbs + (size_t)(mn + r) * 256; }, lane); }
        asm volatile("s_waitcnt lgkmcnt(0)" ::: "memory");
        stage_tile(vst, tc, lane);
        asm volatile("s_waitcnt lgkmcnt(0)" ::: "memory");
        bf16x8 kf[4], vf[2][2]; read_kfrag(kf, vst, lane); read_vfrag(vf, vb);
        f32x16 p = qk_tile(kf, qf);
        softmax_step(p, m, zl, o);
        bf16x8 pw[2]; pack_p(pw, p);
        pv_mma(o, vf, pw);
    }
    float Z; { const auto rr = __builtin_amdgcn_permlane32_swap(__float_as_uint(zl), __float_as_uint(zl), false, false); Z = __uint_as_float(rr[0]) + __uint_as_float(rr[1]); }
    store_o(o, 1.0f / Z, OC + (size_t)(b * S + t0 + i) * NOC + 512 + head * 64, hi);
}
}

constexpr int RING_OFF = 0, RING_BYTES = 131072;
constexpr int LDSCTL_OFF = RING_BYTES, MISC_OFF = LDSCTL_OFF + 320;
constexpr int LDS_BYTES = 147456;
static_assert(att::LDS_BYTES <= RING_BYTES && pg8::STAGE_BYTES <= RING_BYTES && MISC_OFF + 128 <= LDS_BYTES, "LDS map");
#define GAS __attribute__((address_space(1)))
#define LAS __attribute__((address_space(3)))
typedef unsigned v4u __attribute__((ext_vector_type(4)));
typedef float f32x4 __attribute__((ext_vector_type(4)));
typedef GAS unsigned gu32;
#define LDS_WAIT() asm volatile("s_waitcnt lgkmcnt(0)" ::: "memory")
constexpr int CW_BAR = 4096;
#define XB_TMO      128
#define XB_XCNT(j)  (256  + 64 * (j))
#define XB_XSUB(j)  (1280 + 64 * (j))
#define XB_XGEN(j)  (2304 + 64 * (j))
#define XB_TOP      3328
#define XB_TOPGEN   3392
#define XCD_BAR_WORDS 3456
#define XB_SPIN_CAP (1u << 18)

__device__ __forceinline__ unsigned xb_ld(unsigned* p)              { return __hip_atomic_load(p, __ATOMIC_RELAXED, __HIP_MEMORY_SCOPE_AGENT); }
__device__ __forceinline__ unsigned xb_add(unsigned* p, unsigned v) { return __hip_atomic_fetch_add(p, v, __ATOMIC_RELAXED, __HIP_MEMORY_SCOPE_AGENT); }
__device__ __forceinline__ unsigned xb_xcc_id() { return (unsigned)__builtin_amdgcn_s_getreg((3 << 11) | 20) & 0xFu; }
#define XB_SPIN(cond, bar) do { unsigned _sp = 0; while (cond) { __builtin_amdgcn_s_sleep(1); \
    if ((++_sp & 255u) == 0u) { if (xb_ld(&(bar)[XB_TMO])) break; if (_sp > XB_SPIN_CAP) { atomicAdd(&(bar)[XB_TMO], 1u); break; } } } } while (0)

struct XcdBarrier {
    int wave; unsigned* bar; unsigned x;
    volatile LAS unsigned* st;
};

__device__ __forceinline__ bool xb_thread0(int wave) { int ln; asm volatile("v_mbcnt_lo_u32_b32 %0, -1, 0\n\tv_mbcnt_hi_u32_b32 %0, -1, %0" : "=v"(ln)); return ln == 0 && wave == 0; }
__device__ __forceinline__ XcdBarrier xcd_barrier_post(unsigned* bar, volatile LAS unsigned* st, int wave) {
    XcdBarrier b; b.wave = wave; b.bar = bar; b.x = xb_xcc_id(); b.st = st;
    if (xb_thread0(wave)) (void)xb_add(&bar[XB_XCNT(b.x)], 1u);
    return b;
}
__device__ __forceinline__ void xcd_barrier_complete(unsigned* bar, unsigned x, unsigned& nloc, unsigned& nx) {
    const unsigned G = gridDim.x * gridDim.y * gridDim.z;
    unsigned sum, cnt, mine, sp = 0u;
    for (;;) {
        sum = 0u; cnt = 0u; mine = 0u;
#pragma unroll
        for (unsigned j = 0; j < 16; ++j) { const unsigned c = xb_ld(&bar[XB_XCNT(j)]); sum += c; cnt += (c > 0u) ? 1u : 0u; mine = (j == x) ? c : mine; }
        if (sum == G) break;
        __builtin_amdgcn_s_sleep(1);
        if ((++sp & 255u) == 0u) { if (xb_ld(&bar[XB_TMO])) break; if (sp > XB_SPIN_CAP) { atomicAdd(&bar[XB_TMO], 1u); break; } }
    }
    nloc = mine > 0u ? mine : 1u; nx = cnt > 0u ? cnt : 1u;
}

__device__ __forceinline__ void xcd_barrier(const XcdBarrier& b) {
    asm volatile("s_waitcnt vmcnt(0)" ::: "memory");
    __syncthreads();
    if (xb_thread0(b.wave)) {
        unsigned* bar = b.bar;
        __builtin_amdgcn_s_waitcnt(0);
        unsigned nloc = b.st[0], nx = b.st[1];
        if (nloc == 0u) { xcd_barrier_complete(bar, b.x, nloc, nx); b.st[0] = nloc; b.st[1] = nx; }
        const unsigned old = xb_add(&bar[XB_XSUB(b.x)], 1u);
        const unsigned gen = old / nloc;
        if (old + 1u == (gen + 1u) * nloc) {
            __builtin_amdgcn_fence(__ATOMIC_RELEASE, "agent");
            asm volatile("s_waitcnt vmcnt(0)" ::: "memory");
            const unsigned og = xb_add(&bar[XB_TOP], 1u);
            const unsigned tg = og / nx;
            if (og + 1u == (tg + 1u) * nx) xb_add(&bar[XB_TOPGEN], 1u);
            else XB_SPIN(xb_ld(&bar[XB_TOPGEN]) == tg, bar);
            __builtin_amdgcn_fence(__ATOMIC_ACQUIRE, "agent");
            xb_add(&bar[XB_XGEN(b.x)], 1u);
            asm volatile("s_waitcnt vmcnt(0)" ::: "memory");
        } else {
            XB_SPIN(xb_ld(&bar[XB_XGEN(b.x)]) == gen, bar);
            __builtin_amdgcn_fence(__ATOMIC_ACQUIRE, "agent");
            asm volatile("s_waitcnt vmcnt(0)" ::: "memory");
        }
    }
    __syncthreads();

}

#ifndef PROBE_SEL
#define PROBE_SEL(b) true
#endif
#ifndef EXTRA_BAR
#define EXTRA_BAR 0
#endif
#ifndef PROBE_BLOCK
#define PROBE_BLOCK 255
#endif
#ifndef PROBE_P0
#define PROBE_P0 0
#endif
#define P0_PROBE_BEGIN(k) unsigned long long pp0_##k = 0; if (PROBE_P0 == k) pp0_##k = __builtin_amdgcn_s_memrealtime()
#define P0_PROBE_END(k) do { if (PROBE_P0 == k) { const unsigned long long t1_ = __builtin_amdgcn_s_memrealtime(), d_ = t1_ - pp0_##k; while (__builtin_amdgcn_s_memrealtime() - t1_ < d_) __builtin_amdgcn_s_sleep(8); } } while (0)
struct Frame {
    LAS unsigned char* lds;
    volatile LAS unsigned* MISC;
    gu32* ctl;
    int wave, vcu, G;
};
__device__ __forceinline__ int lane_now() { int ln; asm volatile("v_mbcnt_lo_u32_b32 %0, -1, 0\n\tv_mbcnt_hi_u32_b32 %0, -1, %0" : "=v"(ln)); return ln; }

__device__ __forceinline__ unsigned pk2(float lo, float hi) { return (unsigned)f2bf(lo) | ((unsigned)f2bf(hi) << 16); }
__device__ __forceinline__ int dest_row(int kind, int n0) {
    if (kind == 1) return n0 < FF ? (n0 >> 7) * 256 + (n0 & 127) : ((n0 - FF) >> 7) * 256 + 128 + ((n0 - FF) & 127);
    if (kind == 2) { const int l = n0 & 255;
        if (n0 < NQKV) return (n0 & ~255) + (((l >> 5) & 1) << 7) + ((l >> 6) << 5) + (l & 31);
        return (n0 & ~255) + (((l >> 3) & 1) << 7) + ((l >> 6) << 5) + (((l >> 4) & 3) << 3) + (l & 7); }
    return n0;
}
__device__ __forceinline__ void p0_item_load(f32x4 (&v)[8], const float* W, const float* gain, int N, int item, int lane) {
    const int nblk = N / 32, kb = item / nblk, nb = item % nblk, k0 = 64 * kb, n0 = 32 * nb;
#pragma unroll
    for (int i = 0; i < 8; ++i) { const int kk = 8 * i + (lane >> 3); const float g = gain ? gain[k0 + kk] : 1.0f;
        v[i] = __builtin_nontemporal_load((const GAS f32x4*)(W + (size_t)(k0 + kk) * N + n0 + 4 * (lane & 7))) * g; }
}
__device__ __forceinline__ void p0_item_finish(const f32x4 (&v)[8], int N, bf16_t* WT, int kind, int ldk, int koff, LAS float* scr, int item, int lane) {
    const int nblk = N / 32, kb = item / nblk, nb = item % nblk, k0 = 64 * kb, n0 = 32 * nb;
#pragma unroll
    for (int i = 0; i < 8; ++i) { LAS float* d = scr + (8 * i + (lane >> 3)) * 33 + 4 * (lane & 7); d[0] = v[i].x; d[1] = v[i].y; d[2] = v[i].z; d[3] = v[i].w; }
    LDS_WAIT(); asm volatile("" ::: "memory");
    const int c = lane & 7;
#pragma unroll
    for (int j = 0; j < 4; ++j) { const int n = (lane >> 3) + 8 * j, r0 = dest_row(kind, n0 + 8 * j) - 8 * j; const LAS float* s = scr + (8 * c) * 33 + n;
        v4u o; o.x = pk2(s[0 * 33], s[1 * 33]); o.y = pk2(s[2 * 33], s[3 * 33]); o.z = pk2(s[4 * 33], s[5 * 33]); o.w = pk2(s[6 * 33], s[7 * 33]);
        *(GAS v4u*)(WT + (size_t)(r0 + n) * ldk + koff + k0 + 8 * c) = o; }
    LDS_WAIT(); asm volatile("" ::: "memory");
}
__device__ __forceinline__ float wave_sum(float v) {
#pragma unroll
    for (int o = 1; o < 64; o <<= 1) v += __shfl_xor(v, o);
    return v;
}
__device__ __forceinline__ void p0_row(const float* xrow, bf16_t* orow, float* rstd, int lane) {
    const GAS f32x4* xr = (const GAS f32x4*)xrow + lane;
    f32x4 v[4]; float s = 0.f;
#pragma unroll
    for (int j = 0; j < 4; ++j) { v[j] = xr[64 * j]; s += (v[j].x * v[j].x + v[j].y * v[j].y) + (v[j].z * v[j].z + v[j].w * v[j].w); }
    s = wave_sum(s);
    GAS unsigned long long* o8 = (GAS unsigned long long*)orow + lane;
#pragma unroll
    for (int j = 0; j < 4; ++j) o8[64 * j] = (unsigned long long)pk2(v[j].x, v[j].y) | ((unsigned long long)pk2(v[j].z, v[j].w) << 32);
    if (lane == 0) *rstd = 1.0f / sqrtf(s * (1.0f / D) + EPS);
}
#ifndef USE_FOLD
#define USE_FOLD 0
#endif
#ifndef P4_REP_DIL
#define P4_REP_DIL 0
#endif
#ifndef P4_REP_MEM
#define P4_REP_MEM 0
#endif
#ifndef P4_REP_SB
#define P4_REP_SB 0
#endif
#ifndef P5_REP
#define P5_REP 0
#endif
#ifndef P0_REP_T
#define P0_REP_T 0
#endif
#ifndef P0_REP_R
#define P0_REP_R 0
#endif
struct WItem { const float* W; const float* gain; bf16_t* WT; int K, N, kind, ldk, koff; };
__device__ __forceinline__ void p0_prologue(Frame& F, const Ptrs& P) {
    unsigned char* ws = P.ws; const int lane_ = lane_now(), tid_ = F.wave * 64 + lane_;
    P0_PROBE_BEGIN(1);
    for (int u = F.vcu; u < 256; u += F.G) {
        typedef short bf16x8_t __attribute__((ext_vector_type(8))); typedef float f32x16_t __attribute__((ext_vector_type(16)));
        const int rg = u >> 3, hd = u & 7, head = hd & 3, r0 = rg * 32, kb = 128 * F.wave, mi = lane_ & 31, hi = lane_ >> 5;
        LAS float* part = (LAS float*)(F.lds + F.wave * 16384);
        f32x4 av[8][2], gv[8][2]; float wv[8][2][8];
        const float* mrow = P.mem + (size_t)(r0 + mi) * D + kb + 8 * hi; const float* grow = P.mem_norm + kb + 8 * hi;
        const float* wp = P.w_mem_kv + (size_t)(kb + 8 * hi) * 512 + hd * 64 + mi;
#pragma unroll
        for (int s = 0; s < 8; ++s) { av[s][0] = *(const GAS f32x4*)(mrow + 16 * s); av[s][1] = *(const GAS f32x4*)(mrow + 16 * s + 4); gv[s][0] = *(const GAS f32x4*)(grow + 16 * s); gv[s][1] = *(const GAS f32x4*)(grow + 16 * s + 4);
#pragma unroll
            for (int t = 0; t < 2; ++t)
#pragma unroll
                for (int j = 0; j < 8; ++j) wv[s][t][j] = wp[(size_t)(16 * s + j) * 512 + 32 * t]; }
        f32x16_t acc[2]; float sq = 0.f;
#pragma unroll
        for (int r = 0; r < 16; ++r) { acc[0][r] = 0.f; acc[1][r] = 0.f; }
#pragma unroll
        for (int s = 0; s < 8; ++s) { const f32x4 a0 = av[s][0], a1 = av[s][1]; sq += (a0.x * a0.x + a0.y * a0.y) + (a0.z * a0.z + a0.w * a0.w) + (a1.x * a1.x + a1.y * a1.y) + (a1.z * a1.z + a1.w * a1.w);
            const f32x4 b0 = a0 * gv[s][0], b1 = a1 * gv[s][1];
            const v4u bw = {pk2(b0.x, b0.y), pk2(b0.z, b0.w), pk2(b1.x, b1.y), pk2(b1.z, b1.w)};
#pragma unroll
            for (int t = 0; t < 2; ++t) { const v4u aw = {pk2(wv[s][t][0], wv[s][t][1]), pk2(wv[s][t][2], wv[s][t][3]), pk2(wv[s][t][4], wv[s][t][5]), pk2(wv[s][t][6], wv[s][t][7])};
                acc[t] = __builtin_amdgcn_mfma_f32_32x32x16_bf16(__builtin_bit_cast(bf16x8_t, aw), __builtin_bit_cast(bf16x8_t, bw), acc[t], 0, 0, 0); } }
#pragma unroll
        for (int t = 0; t < 2; ++t)
#pragma unroll
            for (int r = 0; r < 16; ++r) part[(t * 16 + r) * 64 + lane_] = acc[t][r];
        part[2048 + lane_] = sq;
        __syncthreads();
        if (F.wave == 0) {
            float v[2][16]; float q = 0.f;
#pragma unroll
            for (int t = 0; t < 2; ++t)
#pragma unroll
                for (int r = 0; r < 16; ++r) { float s = 0.f;
#pragma unroll
                    for (int w8 = 0; w8 < 8; ++w8) s += ((const LAS float*)(F.lds + w8 * 16384))[(t * 16 + r) * 64 + lane_];
                    v[t][r] = s; }
#pragma unroll
            for (int w8 = 0; w8 < 8; ++w8) q += ((const LAS float*)(F.lds + w8 * 16384))[2048 + lane_];
            q += __shfl_xor(q, 32);
            const float rs = 1.0f / sqrtf(q * (1.0f / D) + EPS);
            float hs = 0.f;
#pragma unroll
            for (int t = 0; t < 2; ++t)
#pragma unroll
                for (int r = 0; r < 16; ++r) { v[t][r] *= rs; hs += v[t][r] * v[t][r]; }
            hs += __shfl_xor(hs, 32);
            const float hr = 1.0f / sqrtf(hs * (1.0f / HD) + EPS);
            bf16_t* orow = (bf16_t*)(ws + (hd < 4 ? WS_MK : WS_MVT)) + (size_t)(r0 + mi) * 256 + head * 64;
#pragma unroll
            for (int t = 0; t < 2; ++t)
#pragma unroll
                for (int g4 = 0; g4 < 4; ++g4) { const int n0 = 32 * t + 8 * g4 + 4 * hi; float o4[4];
#pragma unroll
                    for (int i = 0; i < 4; ++i) o4[i] = hd < 4 ? v[t][4 * g4 + i] * hr * P.x_k_gain[n0 + i] : v[t][4 * g4 + i];
                    *(unsigned long long*)(orow + n0) = (unsigned long long)pk2(o4[0], o4[1]) | ((unsigned long long)pk2(o4[2], o4[3]) << 32); }
        }
        __syncthreads();
    }
    P0_PROBE_END(1);
    if (F.vcu == 0 && tid_ < 129) { float* BIAS = (float*)(ws + WS_BIAS);
        for (int g = 0; g < 3; ++g) for (int hh = 0; hh < 2; ++hh) BIAS[(g * 2 + hh) * 129 + tid_] = P.rel_bias[T5B[g][tid_] * 6 + g * 2 + hh] * LOG2E; }
    LAS float* scr = (LAS float*)(F.lds + F.wave * 16384);
    const int gw = F.vcu * 8 + F.wave, NGW = F.G * 8;
    const WItem items[9] = {
        {P.ffn1_w_gu, P.ffn1_norm, (bf16_t*)(ws + WS_WGU1), D, NGU, 1, D, 0}, {P.w_in, P.mix_norm, (bf16_t*)(ws + WS_WIN), D, INCOLS, 2, D, 0}, {P.ffn2_w_gu, P.ffn2_norm, (bf16_t*)(ws + WS_WGU2), D, NGU, 1, D, 0},
        {P.ffn1_w_down, nullptr, (bf16_t*)(ws + WS_WD1), FF, D, 0, FF, 0}, {P.ffn2_w_down, nullptr, (bf16_t*)(ws + WS_WD2), FF, D, 0, FF, 0}, {P.w_out, nullptr, (bf16_t*)(ws + WS_WOUT), D, D, 0, D, 0},
        {P.w_br_sb, nullptr, (bf16_t*)(ws + WS_WSB), 384, D, 0, NOC, 0}, {P.w_br_dil, nullptr, (bf16_t*)(ws + WS_WSB), 128, D, 0, NOC, 384}, {P.w_br_x, nullptr, (bf16_t*)(ws + WS_WSB), 256, D, 0, NOC, 512}};
    P0_PROBE_BEGIN(2);
    {
        int cum[10]; cum[0] = 0;
#pragma unroll
        for (int w = 0; w < 9; ++w) cum[w + 1] = cum[w] + (items[w].K / 64) * (items[w].N / 32);
        const int total = cum[9];
        f32x4 va[8], vb[8];
#define P0_LOCATE(G_, w_) int w_ = 0; _Pragma("unroll") for (int q_ = 1; q_ < 9; ++q_) w_ += ((G_) >= cum[q_]) ? 1 : 0
#define P0_LOAD(V_, G_) do { P0_LOCATE(G_, w__); const float* W__ = items[0].W; const float* g__ = items[0].gain; int N__ = items[0].N, c__ = 0; \
            _Pragma("unroll") for (int q_ = 1; q_ < 9; ++q_) if (w__ == q_) { W__ = items[q_].W; g__ = items[q_].gain; N__ = items[q_].N; c__ = cum[q_]; } \
            p0_item_load(V_, W__, g__, N__, (G_) - c__, lane_); } while (0)
#define P0_FINISH(V_, G_) do { P0_LOCATE(G_, w__); bf16_t* T__ = items[0].WT; int N__ = items[0].N, k__ = items[0].kind, l__ = items[0].ldk, o__ = items[0].koff, c__ = 0; \
            _Pragma("unroll") for (int q_ = 1; q_ < 9; ++q_) if (w__ == q_) { T__ = items[q_].WT; N__ = items[q_].N; k__ = items[q_].kind; l__ = items[q_].ldk; o__ = items[q_].koff; c__ = cum[q_]; } \
            p0_item_finish(V_, N__, T__, k__, l__, o__, scr, (G_) - c__, lane_); } while (0)
        int G = gw;
        if (G < total) P0_LOAD(va, G);
        for (; G < total; G += 2 * NGW) {
            if (G + NGW < total) P0_LOAD(vb, G + NGW);
            P0_FINISH(va, G);
            if (G + NGW < total) { if (G + 2 * NGW < total) P0_LOAD(va, G + 2 * NGW); P0_FINISH(vb, G + NGW); }
        }
#undef P0_LOCATE
#undef P0_LOAD
#undef P0_FINISH
    }
    P0_PROBE_END(2);
    P0_PROBE_BEGIN(3);
    for (int m = gw; m < M; m += 4 * NGW) {
        f32x4 v[4][4];
#pragma unroll
        for (int q = 0; q < 4; ++q) { const int mq = (m + q * NGW < M) ? m + q * NGW : m; const GAS f32x4* xr = (const GAS f32x4*)(P.x + (size_t)mq * D) + lane_;
#pragma unroll
            for (int j = 0; j < 4; ++j) v[q][j] = __builtin_nontemporal_load(xr + 64 * j); }
#pragma unroll
        for (int q = 0; q < 4; ++q) { const int mq = m + q * NGW; if (mq < M) { float s = 0.f;
#pragma unroll
            for (int j = 0; j < 4; ++j) s += (v[q][j].x * v[q][j].x + v[q][j].y * v[q][j].y) + (v[q][j].z * v[q][j].z + v[q][j].w * v[q][j].w);
            s = wave_sum(s);
            GAS unsigned long long* o8 = (GAS unsigned long long*)((bf16_t*)(ws + WS_XB) + (size_t)mq * D) + lane_;
#pragma unroll
            for (int j = 0; j < 4; ++j) o8[64 * j] = (unsigned long long)pk2(v[q][j].x, v[q][j].y) | ((unsigned long long)pk2(v[q][j].z, v[q][j].w) << 32);
            if (lane_ == 0) ((float*)(ws + WS_RSTD0))[mq] = 1.0f / sqrtf(s * (1.0f / D) + EPS); } }
    }
    P0_PROBE_END(3);
}

#ifndef PROBE_PHASE
#define PROBE_PHASE -1
#endif
#ifndef REP_MASK
#define REP_MASK 0x0
#endif
constexpr int NPHASE = 9;
struct Args { Ptrs P; int ph_lo, ph_hi, use_bar, rep; };
__global__ void __launch_bounds__(512, 2) mega_fwd(Args args) {
    extern __shared__ __attribute__((aligned(16))) unsigned char lds[];
    Frame F;
    F.lds = (LAS unsigned char*)lds;
    F.MISC = (volatile LAS unsigned*)(F.lds + MISC_OFF);
    F.wave = __builtin_amdgcn_readfirstlane(threadIdx.x >> 6);
    F.G = gridDim.x; { const int bx = blockIdx.x; F.vcu = (F.G % 8 == 0) ? (bx % 8) * (F.G / 8) + bx / 8 : bx; }
    const Ptrs& P = args.P;
    unsigned char* ws = P.ws;
    F.ctl = (gu32*)(ws + WS_CTL);
    for (int u = F.wave * 64 + lane_now(); u < (LDS_BYTES - LDSCTL_OFF) / 4; u += 512) ((LAS unsigned*)(F.lds + LDSCTL_OFF))[u] = 0u;
    __syncthreads();
    XcdBarrier bar; bar.wave = F.wave; bar.bar = (unsigned*)(F.ctl + CW_BAR); bar.x = 0; bar.st = nullptr;
    if (args.use_bar) bar = xcd_barrier_post((unsigned*)(F.ctl + CW_BAR), F.MISC + 8, F.wave);
    const int lo = args.ph_lo, hi = args.ph_hi;
#define IN(k) (lo <= (k) && (k) < hi)
#define SEAM(k) do { if (IN(k) && IN((k) + 1)) { xcd_barrier(bar); if (EXTRA_BAR) xcd_barrier(bar); } PROBE_AT(k); } while (0)
#if PROBE_PHASE >= 0
    unsigned long long pr_t0 = __builtin_amdgcn_s_memrealtime();
#define PROBE_AT(k) do { if ((k) + 1 == PROBE_PHASE) pr_t0 = __builtin_amdgcn_s_memrealtime(); \
        if ((k) == PROBE_PHASE) { if (PROBE_SEL(blockIdx.x)) { const unsigned long long t1_ = __builtin_amdgcn_s_memrealtime(), d_ = t1_ - pr_t0; while (__builtin_amdgcn_s_memrealtime() - t1_ < d_) __builtin_amdgcn_s_sleep(8); __syncthreads(); } } } while (0)
#else
#define PROBE_AT(k) do { } while (0)
#endif
    bf16_t *XB = (bf16_t*)(ws + WS_XB), *OC = (bf16_t*)P.out  , *H = (bf16_t*)(ws + WS_BIG), *QKV = H; unsigned char* G = ws + WS_G;
    bf16_t* MERGED = (bf16_t*)(ws + WS_BIG + 64 * MiB);
    bf16_t* MACC = (bf16_t*)(ws + WS_BIG); float *SS1 = (float*)(ws + WS_SS1), *SS2 = (float*)(ws + WS_SS2), *RSTD0 = (float*)(ws + WS_RSTD0);
    const int cblk = (int)blockIdx.x;

    _Pragma("unroll") for (int rp_ = 0; rp_ <= ((REP_MASK >> 0) & 1); ++rp_) if (IN(0)) { if (rp_) xcd_barrier(bar); p0_prologue(F, P); } SEAM(0);
    _Pragma("unroll") for (int rp_ = 0; rp_ <= ((REP_MASK >> 1) & 1); ++rp_) if (IN(1)) { if (rp_) xcd_barrier(bar); pg8::Gemm g{XB, (const bf16_t*)(ws + WS_WGU1), M, NGU, D, D, D}; pg8::StaticOrder So; So.init(M, NGU, F.G, cblk);
        pg8::EpiFfnUp E{H, RSTD0, nullptr}; pg8::gemm_phase(F.lds, g, So, E, F.wave); } SEAM(1);
    _Pragma("unroll") for (int rp_ = 0; rp_ <= ((REP_MASK >> 2) & 1); ++rp_) if (IN(2)) { if (rp_) xcd_barrier(bar); pg8::Gemm g{H, (const bf16_t*)(ws + WS_WD1), M, D, FF, FF, FF}; pg8::StaticOrder So; So.init(M, D, F.G, cblk);
        pg8::EpiResB E{XB, SS1, 0.5f};   pg8::gemm_phase(F.lds, g, So, E, F.wave); } SEAM(2);
    _Pragma("unroll") for (int rp_ = 0; rp_ <= ((REP_MASK >> 3) & 1); ++rp_) if (IN(3)) { if (rp_) xcd_barrier(bar); pg8::Gemm g{XB, (const bf16_t*)(ws + WS_WIN), M, INCOLS, D, D, D}; pg8::StaticOrder So; So.init(M, INCOLS, F.G, cblk);
        pg8::EpiWin E{QKV, G, SS1, P.dil_q_gain, P.dil_k_gain, P.x_q_gain, nullptr, (bf16_t*)(ws + 57 * MiB)}; pg8::gemm_phase(F.lds, g, So, E, F.wave); } SEAM(3);
    _Pragma("unroll") for (int rp_ = 0; rp_ <= ((REP_MASK >> 4) & 1); ++rp_) if (IN(4)) { if (rp_) xcd_barrier(bar);
        LAS float* tbl = (LAS float*)(F.lds + att::LDS_TBL); const float* BIAS = (const float*)(ws + WS_BIAS); const int lane_ = lane_now();
        for (int e = F.wave * 64 + lane_; e < 6 * att::TBLN; e += 512) { const int t = e / att::TBLN, s = e % att::TBLN; tbl[e] = (s >= 1 && s <= 129) ? BIAS[t * 129 + s - 1] : att::NEG; }
        __syncthreads();
        LAS unsigned char* vst = F.lds + att::LDS_VST + F.wave * att::WSTAGE;
        const int gw = F.vcu * 8 + F.wave, NGW = F.G * 8;
        if (F.G == 256) {
            bf16_t* PART = (bf16_t*)((unsigned char*)P.out + 64 * MiB); float* LSE = (float*)((unsigned char*)P.out + 96 * MiB);
            const bool dilb = F.vcu < 128; const int v2 = F.vcu - 128;
            P0_PROBE_BEGIN(31);
            if (dilb) { const int b = F.vcu >> 5, hh = (F.vcu >> 4) & 1, span = F.vcu & 15;
                for (int k = 0; k < 6; ++k) { const int wu = F.wave + 8 * k;
                    if (wu < 16) att::dilg_unit(b, hh, 0, 0, span * 16 + wu, QKV, PART, LSE, tbl, vst, lane_);
                    else if (wu < 32) att::dilg_unit(b, hh, 1, (wu - 16) & 3, span * 4 + ((wu - 16) >> 2), QKV, PART, LSE, tbl, vst, lane_);
                    else att::dilg_unit(b, hh, 2, wu - 32, span, QKV, PART, LSE, tbl, vst, lane_); }
            }
            P0_PROBE_END(31);
            const int nsb = dilb ? 2 : 4, sb0 = dilb ? F.vcu * 2 : 256 + v2 * 4, nme = dilb ? 1 : 3, me0 = dilb ? F.vcu : 128 + v2 * 3;
            P0_PROBE_BEGIN(32);
            for (int j = 0; j < nme; ++j) att::mem_unit((me0 + j) * 8 + F.wave, QKV, (const bf16_t*)(ws + WS_MK), (const bf16_t*)(ws + WS_MVT), OC, vst, lane_);
            P0_PROBE_END(32);
            P0_PROBE_BEGIN(33);
            for (int j = 0; j < nsb; ++j) att::sb_unit((sb0 + j) * 8 + F.wave, QKV, OC, vst, lane_);
            P0_PROBE_END(33);
            if (dilb) { asm volatile("s_waitcnt vmcnt(0)" ::: "memory"); __syncthreads();
                att::dil_combine(F.vcu >> 5, (F.vcu >> 4) & 1, (F.vcu & 15) * 512 + F.wave * 64, 64, PART, LSE, OC, lane_); }
        } else {
            for (int id = gw; id < 2048; id += NGW) att::dil_unit(id, QKV, OC, tbl, vst, lane_);
            for (int id = gw; id < 4096; id += NGW) att::mem_unit(id, QKV, (const bf16_t*)(ws + WS_MK), (const bf16_t*)(ws + WS_MVT), OC, vst, lane_);
            for (int id = gw; id < 6144; id += NGW) att::sb_unit(id, QKV, OC, vst, lane_);
        }
        asm volatile("s_waitcnt vmcnt(0) lgkmcnt(0)" ::: "memory"); __syncthreads();
    } SEAM(4);
    _Pragma("unroll") for (int rp_ = 0; rp_ <= ((REP_MASK >> 5) & 1); ++rp_) if (IN(5)) { if (rp_) xcd_barrier(bar);
        pg8::ChainOrder<0, 6, 384, 2, 512, 4> So; So.init(M, D, F.G, cblk);
        pg8::Gemm g{OC, (const bf16_t*)(ws + WS_WSB), M, D, NOC, NOC, NOC}; pg8::EpiBranchChain E{G, MACC, MERGED}; pg8::gemm_phase(F.lds, g, So, E, F.wave); } SEAM(5);
    _Pragma("unroll") for (int rp_ = 0; rp_ <= ((REP_MASK >> 6) & 1); ++rp_) if (IN(6)) { if (rp_) xcd_barrier(bar); pg8::Gemm g{MERGED, (const bf16_t*)(ws + WS_WOUT), M, D, D, D, D}; pg8::StaticOrder So; So.init(M, D, F.G, cblk);
        pg8::EpiResB E{XB, SS2, 1.0f}; pg8::gemm_phase(F.lds, g, So, E, F.wave); } SEAM(6);
    _Pragma("unroll") for (int rp_ = 0; rp_ <= ((REP_MASK >> 7) & 1); ++rp_) if (IN(7)) { if (rp_) xcd_barrier(bar); pg8::Gemm g{XB, (const bf16_t*)(ws + WS_WGU2), M, NGU, D, D, D}; pg8::StaticOrder So; So.init(M, NGU, F.G, cblk);
        pg8::EpiFfnUp E{H, nullptr, SS2}; pg8::gemm_phase(F.lds, g, So, E, F.wave); } SEAM(7);
    _Pragma("unroll") for (int rp_ = 0; rp_ <= ((REP_MASK >> 8) & 1); ++rp_) if (IN(8)) { if (rp_) xcd_barrier(bar); pg8::Gemm g{H, (const bf16_t*)(ws + WS_WD2), M, D, FF, FF, FF}; pg8::StaticOrder So; So.init(M, D, F.G, cblk);
        pg8::EpiResOut E{XB, P.out, 0.5f}; pg8::gemm_phase(F.lds, g, So, E, F.wave); }
    PROBE_AT(8);
#undef IN
#undef SEAM
}

extern "C" void kernel_launch(void* const* d_in, const int* in_sizes, int n_in, void* d_out, int out_size, void* d_ws, size_t ws_size, hipStream_t stream) {
    static int grid = 0;
    if (grid == 0) {
        if (n_in != 21 || out_size != M * D || ws_size < WS_END) { fprintf(stderr, "kernel_launch: unexpected shapes (n_in %d out %d ws %zu)\n", n_in, out_size, ws_size); grid = -1; return; }
        int dev = 0, cus = 0, per_cu = 0;
        if (hipGetDevice(&dev) != hipSuccess || hipDeviceGetAttribute(&cus, hipDeviceAttributeMultiprocessorCount, dev) != hipSuccess) { grid = -1; return; }
        if (hipFuncSetAttribute((const void*)mega_fwd, hipFuncAttributeMaxDynamicSharedMemorySize, LDS_BYTES) != hipSuccess) { fprintf(stderr, "kernel_launch: hipFuncSetAttribute failed\n"); grid = -1; return; }
        if (hipOccupancyMaxActiveBlocksPerMultiprocessor(&per_cu, (const void*)mega_fwd, 512, LDS_BYTES) != hipSuccess || per_cu < 1) { fprintf(stderr, "kernel_launch: occupancy query says %d blocks per CU\n", per_cu); grid = -1; (void)hipGetLastError(); return; }
        (void)hipGetLastError();
        grid = cus;
    }
    if (grid < 0) return;
    Args a{};
    { const float** pp = (const float**)&a.P; for (int i = 0; i < 21; ++i) pp[i] = (const float*)d_in[i]; }
    a.P.out = (float*)d_out; a.P.ws = (unsigned char*)d_ws;
    unsigned char* ws = a.P.ws;
    (void)hipMemsetAsync(ws + WS_CTL, 0, CTL_ZERO_BYTES, stream);
    a.ph_lo = 0; a.ph_hi = NPHASE; a.use_bar = 1;
    hipLaunchKernelGGL(mega_fwd, dim3(grid), dim3(512), LDS_BYTES, stream, a);
    return;
}
```
